# Optimizing an MI355X kernel written in HIP

```python
import math
import jax, jax.numpy as jnp
from jax import lax
import numpy as np

D_MODEL = 2048
BATCH = 1
SEQ = 8192
DEPTH = 1

CHUNK = 64
Q_BLOCK = 128
FOX_HEADS = 8
FOX_HEAD_DIM = 128
FOX_WIDTH = FOX_HEADS * FOX_HEAD_DIM
HG_HEADS = 8
HG_KEY_DIM = 128
HG_VAL_DIM = 128
HG_KW = HG_HEADS * HG_KEY_DIM
HG_VW = HG_HEADS * HG_VAL_DIM
PEER_HEADS = 8
PEER_NKEYS = 128
PEER_EXPERTS = PEER_NKEYS * PEER_NKEYS
PEER_DKEY = 256
PEER_HALF = PEER_DKEY // 2
PEER_TOPK = 16
PEER_TOK_BLOCK = 128
EPS = 1e-6
SPLIT_SIZES = (FOX_WIDTH, FOX_WIDTH, FOX_WIDTH, FOX_HEADS,
               HG_KW, HG_KW, HG_VW, HG_VW,
               D_MODEL, D_MODEL)
N_IN = sum(SPLIT_SIZES)

kernel_name = "fox_hgrn2_peer_gated_hybrid"


def rms_norm(x, g):
    xf = x.astype(jnp.float32)
    y = xf * lax.rsqrt(jnp.mean(xf * xf, axis=-1, keepdims=True) + EPS)
    return (y * g.astype(jnp.float32)).astype(x.dtype)


def split_cols(z):
    idx = np.cumsum(np.array(SPLIT_SIZES))[:-1].tolist()
    return jnp.split(z, idx, axis=-1)


def forgetting_attention(q, k, v, log_f):
    B, S, H, Dh = q.shape
    c = jnp.cumsum(log_f, axis=1)
    cT = c.transpose(0, 2, 1)
    nb = S // Q_BLOCK
    qb = q.reshape(B, nb, Q_BLOCK, H, Dh).transpose(1, 0, 2, 3, 4)
    cb = cT.reshape(B, H, nb, Q_BLOCK).transpose(2, 0, 1, 3)
    kpos = jnp.arange(S)
    scale = Dh ** -0.5

    def block(args):
        i, qi, ci = args
        s = jnp.einsum('bqhd,bkhd->bhqk', qi, k,
                       preferred_element_type=jnp.float32) * scale
        bias = ci[..., :, None] - cT[..., None, :]
        qpos = i * Q_BLOCK + jnp.arange(Q_BLOCK)
        mask = kpos[None, :] <= qpos[:, None]
        logits = jnp.where(mask, s + bias, -jnp.inf)
        p = jax.nn.softmax(logits, axis=-1)
        return jnp.einsum('bhqk,bkhd->bqhd', p.astype(v.dtype), v)

    out = lax.map(block, (jnp.arange(nb), qb, cb))
    return out.transpose(1, 0, 2, 3, 4).reshape(B, S, H, Dh)


def hgrn2_recurrence(q, k, v, log_f):
    B, S, H, K = q.shape
    V = v.shape[-1]
    nc = S // CHUNK

    def to_chunks(a):
        return a.reshape(B, nc, CHUNK, H, a.shape[-1]).transpose(1, 0, 3, 2, 4)

    qc, kc, vc, gc = to_chunks(q), to_chunks(k), to_chunks(v), to_chunks(log_f)
    causal = jnp.tril(jnp.ones((CHUNK, CHUNK), dtype=bool))

    def step(state, inp):
        qt, kt, vt, gt = inp
        b = jnp.cumsum(gt, axis=2)
        diff = b[:, :, :, None, :] - b[:, :, None, :, :]
        decay = jnp.exp(jnp.where(causal[None, None, :, :, None], diff, -jnp.inf))
        attn = jnp.einsum('bhtk,bhsk,bhtsk->bhts', qt, kt, decay)
        o = (jnp.einsum('bhts,bhsv->bhtv', attn, vt)
             + jnp.einsum('bhtk,bhkv->bhtv', qt * jnp.exp(b), state))
        b_last = b[:, :, -1:, :]
        new_state = (jnp.exp(b_last[:, :, 0, :])[..., None] * state
                     + jnp.einsum('bhsk,bhsv->bhkv', kt * jnp.exp(b_last - b), vt))
        return new_state, o

    s0 = jnp.zeros((B, H, K, V), jnp.float32)
    _, o = lax.scan(step, s0, (qc, kc, vc, gc))
    return o.transpose(1, 0, 3, 2, 4).reshape(B, S, H, V)


def peer_layer(x, wq, keys, U, Vt):
    B, S, D = x.shape
    T = B * S
    xt = x.reshape(T, D)
    q = (xt @ wq).reshape(T, PEER_HEADS, 2, PEER_HALF)
    scores = jnp.einsum('thcd,hcnd->thcn', q, keys,
                        preferred_element_type=jnp.float32)
    s_top, i_top = lax.top_k(scores, PEER_TOPK)
    cand = s_top[:, :, 0, :, None] + s_top[:, :, 1, None, :]
    cand_idx = i_top[:, :, 0, :, None] * PEER_NKEYS + i_top[:, :, 1, None, :]
    best, pos = lax.top_k(cand.reshape(T, PEER_HEADS, PEER_TOPK * PEER_TOPK), PEER_TOPK)
    idx = jnp.take_along_axis(
        cand_idx.reshape(T, PEER_HEADS, PEER_TOPK * PEER_TOPK), pos, axis=-1)
    gate = jax.nn.softmax(best, axis=-1).astype(x.dtype)

    nb = T // PEER_TOK_BLOCK

    def blk(args):
        xb, ib, gb = args
        u = U[ib]
        hid = jax.nn.gelu(jnp.einsum('td,thkd->thk', xb, u))
        v = Vt[ib]
        return jnp.einsum('thk,thkd->td', gb * hid, v)

    out = lax.map(blk, (xt.reshape(nb, PEER_TOK_BLOCK, D),
                        idx.reshape(nb, PEER_TOK_BLOCK, PEER_HEADS, PEER_TOPK),
                        gate.reshape(nb, PEER_TOK_BLOCK, PEER_HEADS, PEER_TOPK)))
    return out.reshape(B, S, D)


def setup_inputs(seed: int = 0) -> dict:
    key = jax.random.key(seed)
    ks = jax.random.split(key, 16)
    f32 = jnp.float32
    nrm = lambda k, shape, s: (jax.random.normal(k, shape, f32) * s)
    return {
        "x": nrm(ks[0], (BATCH, SEQ, D_MODEL), 1.0),
        "norm1_g": 1.0 + nrm(ks[1], (DEPTH, D_MODEL), 0.02),
        "w_in": nrm(ks[2], (DEPTH, D_MODEL, N_IN), D_MODEL ** -0.5),
        "fox_f_bias": 2.0 + nrm(ks[3], (DEPTH, FOX_HEADS), 0.1),
        "hg_lb_logits": nrm(ks[4], (DEPTH + 1, HG_KW), 0.1),
        "hg_norm_g": 1.0 + nrm(ks[5], (DEPTH, HG_VW), 0.02),
        "w_a_up": nrm(ks[6], (DEPTH, FOX_WIDTH, D_MODEL), FOX_WIDTH ** -0.5),
        "w_b_up": nrm(ks[7], (DEPTH, HG_VW, D_MODEL), HG_VW ** -0.5),
        "w_o": nrm(ks[8], (DEPTH, D_MODEL, D_MODEL), D_MODEL ** -0.5),
        "norm2_g": 1.0 + nrm(ks[9], (DEPTH, D_MODEL), 0.02),
        "peer_wq": nrm(ks[10], (DEPTH, D_MODEL, PEER_HEADS * PEER_DKEY), D_MODEL ** -0.5),
        "peer_keys": nrm(ks[11], (DEPTH, PEER_HEADS, 2, PEER_NKEYS, PEER_HALF), PEER_HALF ** -0.5),
        "peer_u": nrm(ks[12], (DEPTH, PEER_EXPERTS, D_MODEL), D_MODEL ** -0.5),
        "peer_v": nrm(ks[13], (DEPTH, PEER_EXPERTS, D_MODEL), (PEER_HEADS * PEER_TOPK) ** -0.5),
        "norm_f_g": 1.0 + nrm(ks[14], (D_MODEL,), 0.02),
    }


def reference(x, norm1_g, w_in, fox_f_bias, hg_lb_logits, hg_norm_g, w_a_up, w_b_up,
              w_o, norm2_g, peer_wq, peer_keys, peer_u, peer_v, norm_f_g):
    B, S, D = x.shape
    lb_all = jnp.cumsum(jax.nn.softmax(hg_lb_logits.astype(jnp.float32), axis=0), axis=0)
    for l in range(DEPTH):
        h = rms_norm(x, norm1_g[l])
        z = h @ w_in[l]
        fq, fk, fv, ff, hq, hf, hi, hgate, ga, gb = split_cols(z)

        log_fa = jax.nn.log_sigmoid(ff.astype(jnp.float32) + fox_f_bias[l].astype(jnp.float32))
        shp = (B, S, FOX_HEADS, FOX_HEAD_DIM)
        ya = forgetting_attention(fq.reshape(shp), fk.reshape(shp), fv.reshape(shp), log_fa)
        ya = ya.reshape(B, S, FOX_WIDTH) @ w_a_up[l]

        lb = lb_all[l]
        f_gate = lb + (1.0 - lb) * jax.nn.sigmoid(hf.astype(jnp.float32))
        log_fb = jnp.log(f_gate).reshape(B, S, HG_HEADS, HG_KEY_DIM)
        k_in = (1.0 - f_gate).reshape(B, S, HG_HEADS, HG_KEY_DIM)
        q_in = jax.nn.silu(hq.astype(jnp.float32)).reshape(B, S, HG_HEADS, HG_KEY_DIM)
        v_in = hi.astype(jnp.float32).reshape(B, S, HG_HEADS, HG_VAL_DIM)
        ob = hgrn2_recurrence(q_in, k_in, v_in, log_fb)
        ob = ob * lax.rsqrt(jnp.mean(ob * ob, axis=-1, keepdims=True) + EPS)
        ob = ob.reshape(B, S, HG_VW) * hg_norm_g[l].astype(jnp.float32)
        ob = (ob * jax.nn.silu(hgate.astype(jnp.float32))).astype(x.dtype)
        yb = ob @ w_b_up[l]

        merged = jax.nn.sigmoid(ga) * ya + jax.nn.sigmoid(gb) * yb
        x = x + merged @ w_o[l]

        h2 = rms_norm(x, norm2_g[l])
        x = x + peer_layer(h2, peer_wq[l], peer_keys[l], peer_u[l], peer_v[l])
    return rms_norm(x, norm_f_g)
```

```cpp
#include <hip/hip_runtime.h>
#include <hip/hip_cooperative_groups.h>
#include <cstdio>
namespace cg = cooperative_groups;
#define PG8_LAS __attribute__((address_space(3)))
typedef unsigned short bf16_t;
typedef short bf16x8 __attribute__((ext_vector_type(8)));
typedef float f32x4 __attribute__((ext_vector_type(4)));
typedef unsigned u32x4 __attribute__((ext_vector_type(4)));
constexpr int BM = 256, BK = 64, HALF = 128, HTB = HALF * BK * 2  , STAGE_BYTES = 8 * HTB, NXCD = 8, WGM = 8;

__host__ __device__ __forceinline__ int lds_byte(int r, int c) { const int st = (r >> 4) * 2 + (c >> 5), rr = r & 15, cc = c & 31, ob = rr * 64 + cc * 2; return st * 1024 + (ob ^ (((ob >> 9) & 1) << 5)); }
__host__ __device__ __forceinline__ void stage_rc(int b, int& R, int& C) { const int st = b / 1024, sb = b % 1024, swz = sb ^ (((sb >> 9) & 1) << 5); R = (st >> 1) * 16 + swz / 64; C = (st & 1) * 32 + (swz % 64) / 2; }
__host__ __device__ __forceinline__ int perm32(int rho) { const int n = rho >> 4, i = rho & 15; return 8 * (i >> 2) + 4 * n + (i & 3); }

struct Unit { int pm, pn; };
struct Gemm { const bf16_t* A; const bf16_t* Bt; int M, N, K; };

struct StaticOrder {
    int nM, nN, nwg, G, c;
    __host__ __device__ void init(int M, int N, int G_, int c_) { nM = M / BM; nN = N / BM; nwg = nM * nN; G = G_; c = c_; }
    __host__ __device__ bool next(int i, Unit& u) const {
        const long L = (long)i * G + c; if (L >= nwg) return false;
        int wgid = (int)L; { const int q = nwg / NXCD, r = nwg % NXCD, xcd = wgid % NXCD, off = wgid / NXCD; wgid = (xcd < r ? xcd * (q + 1) : r * (q + 1) + (xcd - r) * q) + off; }
        const int nig = WGM * nN, gid = wgid / nig, fm = gid * WGM, gsz = (nM - fm) < WGM ? (nM - fm) : WGM;
        u.pm = fm + ((wgid % nig) % gsz); u.pn = (wgid % nig) / gsz; return true;
    }
    __device__ __forceinline__ void a_ready(const Unit&) const {}
    __device__ __forceinline__ void done(const Unit&) const {}
};
typedef __bf16 bf16x2_t __attribute__((ext_vector_type(2)));
typedef float f32x2_t __attribute__((ext_vector_type(2)));
__device__ __forceinline__ unsigned cvt_pk_bf16(float lo, float hi) { f32x2_t v = {lo, hi}; bf16x2_t r = __builtin_convertvector(v, bf16x2_t); return __builtin_bit_cast(unsigned, r); }
template <class Epi, class Sched>
__device__ __forceinline__ void gemm_phase(PG8_LAS unsigned char* lds, const Gemm g, const Sched& S, const Epi& E) {
    const int tid = threadIdx.x, wid = __builtin_amdgcn_readfirstlane(tid >> 6), lane = tid & 63, wr = wid >> 2, wc = wid & 3, fr = lane & 15, fq = lane >> 4;
    const int K = g.K, nt = K / BK;
    unsigned voffA[2], voffB[2];
#pragma unroll
    for (int i = 0; i < 2; ++i) { int R, C; stage_rc(tid * 16 + i * 8192, R, C); const int Rb = Epi::PERM ? ((R & ~31) + perm32(R & 31)) : R;
        voffA[i] = (unsigned)(R * K + C) * 2u; voffB[i] = (unsigned)(Rb * K + C) * 2u; }
    const size_t kstep = (size_t)(BK * 2);
    const size_t hstep = (size_t)HALF * K * 2;
    const size_t tstep = 2 * hstep;
    const unsigned ldsw = (unsigned)wid * 1024u;
    const int aoff = lds_byte(wr * 64 + fr, fq * 8), boff = lds_byte(wc * 32 + fr, fq * 8);
#define PG8_SA(b, h) (((b) * 2 + (h)) * HTB)
#define PG8_SB(b, h) ((4 + (b) * 2 + (h)) * HTB)
#define PG8_STAGE(bufoff, gbase, voff) do { _Pragma("unroll") for (int _i = 0; _i < 2; ++_i) \
        __builtin_amdgcn_global_load_lds((const unsigned*)((const char*)(gbase) + (voff)[_i]), (PG8_LAS unsigned*)(lds + (bufoff) + ldsw + _i * 8192), 16, 0, 0); } while (0)
#define PG8_LDA(dst, b, h) do { _Pragma("unroll") for (int m = 0; m < 4; ++m) _Pragma("unroll") for (int k = 0; k < 2; ++k) dst[m][k] = *(const PG8_LAS bf16x8*)(lds + PG8_SA(b, h) + aoff + m * 2048 + k * 1024); } while (0)
#define PG8_LDB(dst, b, h) do { _Pragma("unroll") for (int n = 0; n < 2; ++n) _Pragma("unroll") for (int k = 0; k < 2; ++k) dst[n][k] = *(const PG8_LAS bf16x8*)(lds + PG8_SB(b, h) + boff + n * 2048 + k * 1024); } while (0)
#define PG8_MMA(ai, bj, At, Bt) do { __builtin_amdgcn_s_setprio(1); _Pragma("unroll") for (int m = 0; m < 4; ++m) _Pragma("unroll") for (int n = 0; n < 2; ++n) _Pragma("unroll") for (int k = 0; k < 2; ++k) \
        acc[ai][bj][m][n] = __builtin_amdgcn_mfma_f32_16x16x32_bf16(Bt[n][k], At[m][k], acc[ai][bj][m][n], 0, 0, 0); __builtin_amdgcn_s_setprio(0); } while (0)
#define PG8_WAIT_V(n) asm volatile("s_waitcnt vmcnt(" #n ")" ::: "memory")
#define PG8_WAIT_L(n) asm volatile("s_waitcnt lgkmcnt(" #n ")" ::: "memory")
#define PG8_BAR __builtin_amdgcn_s_barrier()
#define PG8_SCHED __builtin_amdgcn_sched_barrier(0)
    Unit cur, nxt; int ui = 0;
    if (!S.next(0, cur)) return;
    f32x4 acc[2][2][4][2];
#pragma unroll
    for (int a = 0; a < 2; ++a)
#pragma unroll
        for (int b = 0; b < 2; ++b)
#pragma unroll
            for (int m = 0; m < 4; ++m)
#pragma unroll
                for (int n = 0; n < 2; ++n) acc[a][b][m][n] = (f32x4){0.f, 0.f, 0.f, 0.f};
    bf16x8 At[4][2], B0[2][2], B1[2][2];
    const char* cA = (const char*)g.A + (size_t)cur.pm * tstep; const char* cB = (const char*)g.Bt + (size_t)cur.pn * tstep;
    S.a_ready(cur);
    PG8_STAGE(PG8_SB(0, 0), cB, voffB); PG8_STAGE(PG8_SA(0, 0), cA, voffA); PG8_STAGE(PG8_SB(0, 1), cB + hstep, voffB); PG8_STAGE(PG8_SA(0, 1), cA + hstep, voffA);
    if (wr == 1) PG8_BAR;
    PG8_WAIT_V(4); PG8_BAR;
    PG8_STAGE(PG8_SB(1, 0), cB + kstep, voffB); PG8_STAGE(PG8_SA(1, 0), cA + kstep, voffA); PG8_STAGE(PG8_SB(1, 1), cB + hstep + kstep, voffB);
    PG8_WAIT_V(6); PG8_BAR;
    for (;;) {
        const bool has_next = S.next(ui + 1, nxt);
        const char* nA = has_next ? (const char*)g.A + (size_t)nxt.pm * tstep : cA; const char* nB = has_next ? (const char*)g.Bt + (size_t)nxt.pn * tstep : cB;
        for (int t = 0; t < nt; t += 2) {
            const bool last = (t == nt - 2);
            const char* a1 = cA + (size_t)(t + 1) * kstep;
            const char* a2 = last ? nA : cA + (size_t)(t + 2) * kstep; const char* b2 = last ? nB : cB + (size_t)(t + 2) * kstep;
            const char* a3 = a2 + kstep; const char* b3 = b2 + kstep;
            if (last && has_next) S.a_ready(nxt);
            PG8_LDB(B0, 0, 0); PG8_SCHED; PG8_LDA(At, 0, 0); PG8_STAGE(PG8_SA(1, 1), a1 + hstep, voffA);
            PG8_WAIT_L(8); PG8_BAR; PG8_WAIT_L(0); PG8_MMA(0, 0, At, B0); PG8_BAR; PG8_SCHED;
            PG8_LDB(B1, 0, 1); PG8_STAGE(PG8_SB(0, 0), b2, voffB);
            PG8_BAR; PG8_WAIT_L(0); PG8_MMA(0, 1, At, B1); PG8_BAR;
            PG8_LDA(At, 0, 1); PG8_STAGE(PG8_SA(0, 0), a2, voffA);
            PG8_BAR; PG8_WAIT_L(0); PG8_MMA(1, 0, At, B0); PG8_BAR; PG8_SCHED;
            PG8_STAGE(PG8_SB(0, 1), b2 + hstep, voffB);
            PG8_WAIT_V(6); PG8_BAR; PG8_MMA(1, 1, At, B1); PG8_BAR;
            PG8_LDB(B0, 1, 0); PG8_SCHED; PG8_LDA(At, 1, 0); PG8_STAGE(PG8_SA(0, 1), a2 + hstep, voffA);
            PG8_WAIT_L(8); PG8_BAR; PG8_WAIT_L(0); PG8_MMA(0, 0, At, B0); PG8_BAR; PG8_SCHED;
            PG8_LDB(B1, 1, 1); PG8_STAGE(PG8_SB(1, 0), b3, voffB);
            PG8_BAR; PG8_WAIT_L(0); PG8_MMA(0, 1, At, B1); PG8_BAR;
            PG8_LDA(At, 1, 1); PG8_STAGE(PG8_SA(1, 0), a3, voffA);
            PG8_BAR; PG8_WAIT_L(0); PG8_MMA(1, 0, At, B0); PG8_BAR; PG8_SCHED;
            PG8_STAGE(PG8_SB(1, 1), b3 + hstep, voffB);
            PG8_WAIT_V(6); PG8_BAR; PG8_MMA(1, 1, At, B1); PG8_BAR;
        }
        if constexpr (!Epi::AFTER_DRAIN) { E(acc, cur, wr, wc, fr, fq); S.done(cur); }
        if (!has_next) break;
#pragma unroll
        for (int a = 0; a < 2; ++a)
#pragma unroll
            for (int b = 0; b < 2; ++b)
#pragma unroll
                for (int m = 0; m < 4; ++m)
#pragma unroll
                    for (int n = 0; n < 2; ++n) acc[a][b][m][n] = (f32x4){0.f, 0.f, 0.f, 0.f};
        cur = nxt; cA = nA; cB = nB; ++ui;
    }
    PG8_WAIT_V(0);
    if (wr == 0) PG8_BAR;
    PG8_BAR;
    if constexpr (Epi::AFTER_DRAIN) { E.fused(acc, cur, wr, wc, fr, fq, lds, wid, lane); S.done(cur); }
#undef PG8_SA
#undef PG8_SB
#undef PG8_STAGE
#undef PG8_LDA
#undef PG8_LDB
#undef PG8_MMA
#undef PG8_WAIT_V
#undef PG8_WAIT_L
#undef PG8_BAR
#undef PG8_SCHED
}
#define LAS PG8_LAS
typedef unsigned u32x2 __attribute__((ext_vector_type(2)));
typedef float f32x2 __attribute__((ext_vector_type(2)));

constexpr int T = 8192, D = 2048, NZ = 11264, NIN_SRC = 11272;
constexpr float EPS = 1e-6f;
constexpr size_t MiB = 1ull << 20;
constexpr size_t OFF_UBF = 0;
constexpr size_t OFF_WIN = 0;
constexpr size_t OFF_QIN = 44 * MiB;
constexpr size_t OFF_V = 60 * MiB;
constexpr size_t OFF_VBF = 76 * MiB;
constexpr size_t OFF_FQ = 76 * MiB, OFF_FK = 92 * MiB, OFF_FV = 108 * MiB;
constexpr size_t OFF_LT = 124 * MiB;
constexpr size_t OFF_WA = 156 * MiB;
constexpr size_t OFF_WB = 160 * MiB;
constexpr size_t OFF_WO = 164 * MiB;
constexpr size_t OFF_WQ = 172 * MiB;
constexpr size_t OFF_KEYS = 180 * MiB;
constexpr size_t OFF_LOGFA = 180 * MiB + 512 * 1024;
constexpr size_t OFF_CFOX = OFF_LOGFA + 256 * 1024;
constexpr size_t OFF_BQ = OFF_CFOX + 256 * 1024;
constexpr size_t OFF_DEC = OFF_BQ + 1024;
constexpr size_t OFF_SUMSQ = 182 * MiB;
constexpr size_t OFF_SGATE = 183 * MiB;
constexpr size_t OFF_SGA = 199 * MiB;
constexpr size_t OFF_SGB = 231 * MiB;
constexpr size_t OFF_ST = 263 * MiB;
constexpr size_t OFF_OINTRA = 295 * MiB;
constexpr size_t OFF_QE = 327 * MiB;
constexpr size_t OFF_YA = 343 * MiB;
constexpr size_t OFF_OB = 359 * MiB;
constexpr size_t OFF_MERGED = 375 * MiB;
constexpr size_t OFF_XG2 = 407 * MiB;
constexpr size_t OFF_QP = 439 * MiB;
constexpr size_t OFF_IDX = 471 * MiB;
constexpr size_t OFF_GATE = 475 * MiB;
constexpr size_t WS_END = 479 * MiB;
constexpr size_t OUT_LOGF = 32 * MiB;
constexpr int LDS_BYTES = 131072;

struct Params {
    const float *x, *norm1_g, *w_in, *fox_f_bias, *hg_lb_logits, *hg_norm_g, *w_a_up, *w_b_up, *w_o, *norm2_g, *peer_wq, *peer_keys, *peer_u, *peer_v, *norm_f_g;
    float* out; unsigned char* ws;
};

__device__ __forceinline__ float bf2f(bf16_t b) { return __uint_as_float(((unsigned)b) << 16); }
__device__ __forceinline__ float bflo(unsigned u) { return __uint_as_float(u << 16); }
__device__ __forceinline__ float bfhi(unsigned u) { return __uint_as_float(u & 0xffff0000u); }
__device__ __forceinline__ bf16_t f2bf(float f) { return (bf16_t)(cvt_pk_bf16(f, 0.f) & 0xffffu); }
__device__ __forceinline__ float wave_sum(float v) {
#pragma unroll
    for (int o = 32; o > 0; o >>= 1) v += __shfl_xor(v, o);
    return v;
}
__device__ __forceinline__ float sigmoidf_(float x) { return 1.f / (1.f + __expf(-x)); }
__device__ __forceinline__ float siluf_(float x) { return x / (1.f + __expf(-x)); }
__device__ __forceinline__ f32x4 mfma16(bf16x8 a, bf16x8 b, f32x4 c) { return __builtin_amdgcn_mfma_f32_16x16x32_bf16(a, b, c, 0, 0, 0); }
__device__ __forceinline__ unsigned cvt_pk_bf16_asm(float lo, float hi) { unsigned r; asm volatile("v_cvt_pk_bf16_f32 %0, %1, %2" : "=v"(r) : "v"(lo), "v"(hi)); return r; }
__device__ __forceinline__ u32x4 pack8(const float* v) { u32x4 o; o[0] = cvt_pk_bf16_asm(v[0], v[1]); o[1] = cvt_pk_bf16_asm(v[2], v[3]); o[2] = cvt_pk_bf16_asm(v[4], v[5]); o[3] = cvt_pk_bf16_asm(v[6], v[7]); return o; }

__device__ __forceinline__ float row_rstd(const float* ssp, int row) {
    const f32x4* q = (const f32x4*)(ssp + (size_t)row * 32); float s = 0.f;
#pragma unroll
    for (int i = 0; i < 8; ++i) { const f32x4 v = q[i]; s += (v[0] + v[1]) + (v[2] + v[3]); }
    return rsqrtf(s * (1.f / 2048.f) + EPS);
}
template <class F> struct EpiRow {
    static constexpr bool PERM = true, AFTER_DRAIN = false;
    F f;
    __device__ __forceinline__ void operator()(const f32x4 (&acc)[2][2][4][2], const Unit& u, int wr, int wc, int fr, int fq) const {
        const int row0 = u.pm * BM + wr * 64 + fr, col0 = u.pn * BM + wc * 32 + 8 * fq;
        asm volatile("s_nop 15\n\ts_nop 15" ::: "memory");
#pragma unroll
        for (int ai = 0; ai < 2; ++ai)
#pragma unroll
            for (int m = 0; m < 4; ++m) {
                const int row = row0 + ai * HALF + m * 16;
                float v[2][8];
#pragma unroll
                for (int bj = 0; bj < 2; ++bj)
#pragma unroll
                    for (int e = 0; e < 4; ++e) { v[bj][e] = acc[ai][bj][m][0][e]; v[bj][4 + e] = acc[ai][bj][m][1][e]; }
                f(row, col0, v[0], col0 + HALF, v[1], u);
            }
    }
};
__device__ __forceinline__ void st8bf(bf16_t* p, const float* v) { *(u32x4*)p = pack8(v); }

struct FZ {
    bf16_t *fq, *fk, *fv, *qin, *v, *sgate, *sga, *sgb; float* logfo; const float* lbl;
    __device__ __forceinline__ void one(int row, int c, const float* a) const {
        const int reg = c >> 10, lc = c & 1023; float o[8];
        const size_t r1 = (size_t)row * 1024 + lc;
        if (reg == 0) {
#pragma unroll
            for (int e = 0; e < 8; ++e) o[e] = a[e] * 0.08838834764831845f;
            st8bf(fq + r1, o);
        } else if (reg == 1) { st8bf(fk + r1, a);
        } else if (reg == 2) { st8bf(fv + r1, a);
        } else if (reg == 3) {
#pragma unroll
            for (int e = 0; e < 8; ++e) o[e] = siluf_(a[e]);
            st8bf(qin + r1, o);
        } else if (reg == 4) {
            const f32x4 l0a = *(const f32x4*)(lbl + lc), l0b = *(const f32x4*)(lbl + lc + 4), l1a = *(const f32x4*)(lbl + 1024 + lc), l1b = *(const f32x4*)(lbl + 1024 + lc + 4);
#pragma unroll
            for (int e = 0; e < 8; ++e) { const float l0 = e < 4 ? l0a[e & 3] : l0b[e & 3], l1 = e < 4 ? l1a[e & 3] : l1b[e & 3];
                const float lb = 1.f / (1.f + __expf(l1 - l0)); const float f = lb + (1.f - lb) * sigmoidf_(a[e]); o[e] = logf(f); }
            *(f32x4*)(logfo + r1) = (f32x4){o[0], o[1], o[2], o[3]}; *(f32x4*)(logfo + r1 + 4) = (f32x4){o[4], o[5], o[6], o[7]};
        } else if (reg == 5) { st8bf(v + r1, a);
        } else if (reg == 6) {
#pragma unroll
            for (int e = 0; e < 8; ++e) o[e] = siluf_(a[e]);
            st8bf(sgate + r1, o);
        } else {
#pragma unroll
            for (int e = 0; e < 8; ++e) o[e] = sigmoidf_(a[e]);
            if (reg < 9) st8bf(sga + (size_t)row * 2048 + (c - 7168), o); else st8bf(sgb + (size_t)row * 2048 + (c - 9216), o);
        }
    }
    __device__ __forceinline__ void operator()(int row, int cA, const float* vA, int cB, const float* vB, const Unit&) const { one(row, cA, vA); one(row, cB, vB); }
};
struct FA {
    bf16_t* merged; const bf16_t* sg;
    __device__ __forceinline__ void one(int row, int c, const float* a) const {
        const size_t o = (size_t)row * 2048 + c; const u32x4 g = *(const u32x4*)(sg + o); float r[8];
#pragma unroll
        for (int e = 0; e < 4; ++e) { r[2 * e] = a[2 * e] * bflo(g[e]); r[2 * e + 1] = a[2 * e + 1] * bfhi(g[e]); }
        st8bf(merged + o, r);
    }
    __device__ __forceinline__ void operator()(int row, int cA, const float* vA, int cB, const float* vB, const Unit&) const { one(row, cA, vA); one(row, cB, vB); }
};
struct FB {
    bf16_t* merged; const bf16_t* sg;
    __device__ __forceinline__ void one(int row, int c, const float* a) const {
        const size_t o = (size_t)row * 2048 + c; const u32x4 g = *(const u32x4*)(sg + o); const u32x4 mm = *(const u32x4*)(merged + o); float r[8];
#pragma unroll
        for (int e = 0; e < 4; ++e) { r[2 * e] = bflo(mm[e]) + a[2 * e] * bflo(g[e]); r[2 * e + 1] = bfhi(mm[e]) + a[2 * e + 1] * bfhi(g[e]); }
        st8bf(merged + o, r);
    }
    __device__ __forceinline__ void operator()(int row, int cA, const float* vA, int cB, const float* vB, const Unit&) const { one(row, cA, vA); one(row, cB, vB); }
};
struct FO {
    const float* x; const float* g2; float* x1; bf16_t* xg2; float* sumsq;
    __device__ __forceinline__ float one(int row, int c, const float* a) const {
        const size_t o = (size_t)row * 2048 + c; const f32x4 xa = *(const f32x4*)(x + o), xb = *(const f32x4*)(x + o + 4), ga = *(const f32x4*)(g2 + c), gb = *(const f32x4*)(g2 + c + 4);
        float r[8], s = 0.f, w[8];
#pragma unroll
        for (int e = 0; e < 8; ++e) { r[e] = a[e] + (e < 4 ? xa[e & 3] : xb[e & 3]); s += r[e] * r[e]; w[e] = r[e] * (e < 4 ? ga[e & 3] : gb[e & 3]); }
        *(f32x4*)(x1 + o) = (f32x4){r[0], r[1], r[2], r[3]}; *(f32x4*)(x1 + o + 4) = (f32x4){r[4], r[5], r[6], r[7]};
        st8bf(xg2 + o, w); return s;
    }
    __device__ __forceinline__ void operator()(int row, int cA, const float* vA, int cB, const float* vB, const Unit& u) const {
        float s = one(row, cA, vA) + one(row, cB, vB);
        s += __shfl_xor(s, 16); s += __shfl_xor(s, 32);
        if ((threadIdx.x & 63) < 16) sumsq[(size_t)row * 32 + u.pn * 4 + ((threadIdx.x >> 6) & 3)] = s;
    }
};
struct FQ {
    bf16_t* qp; const float* sumsq;
    __device__ __forceinline__ void operator()(int row, int cA, const float* vA, int cB, const float* vB, const Unit&) const {
        const float rs = row_rstd(sumsq, row); float r[8];
#pragma unroll
        for (int e = 0; e < 8; ++e) r[e] = vA[e] * rs;
        st8bf(qp + (size_t)row * 2048 + cA, r);
#pragma unroll
        for (int e = 0; e < 8; ++e) r[e] = vB[e] * rs;
        st8bf(qp + (size_t)row * 2048 + cB, r);
    }
};
template <class F> __device__ __forceinline__ void run_gemm(unsigned char* smem, const bf16_t* A, const bf16_t* Bt, int M, int N, int K, const F& f) {
    Gemm g; g.A = A; g.Bt = Bt; g.M = M; g.N = N; g.K = K;
    StaticOrder S; S.init(M, N, (int)gridDim.x, (int)blockIdx.x);
    EpiRow<F> E{f};
    gemm_phase<EpiRow<F>, StaticOrder>((LAS unsigned char*)smem, g, S, E);
    __syncthreads();
}
__device__ __forceinline__ void transpose_tile(const float* src, int ldsrc, int srccol0, bf16_t* dst, int K, int k0, int n0, float* tl) {
    const int tid = threadIdx.x, j = tid & 63, i = tid >> 6;
#pragma unroll
    for (int r = 0; r < 8; ++r) { const int k = r * 8 + i; tl[j * 65 + k] = src[(size_t)(k0 + k) * ldsrc + srccol0 + j]; }
    __syncthreads();
    const int n = tid >> 3, kc = tid & 7; float v[8];
#pragma unroll
    for (int e = 0; e < 8; ++e) v[e] = tl[n * 65 + kc * 8 + e];
    st8bf(dst + (size_t)(n0 + n) * K + k0 + kc * 8, v);
    __syncthreads();
}
__device__ __forceinline__ void cvt_stream(const float* src, bf16_t* dst, size_t n) {
    const size_t nthr = (size_t)gridDim.x * 512, gt = (size_t)blockIdx.x * 512 + threadIdx.x;
    for (size_t i = gt * 8; i < n; i += nthr * 8) {
        const f32x4 a = *(const f32x4*)(src + i), b = *(const f32x4*)(src + i + 4);
        float v[8] = {a[0], a[1], a[2], a[3], b[0], b[1], b[2], b[3]};
        st8bf(dst + i, v);
    }
}
__device__ void phase_prep(const Params& p, unsigned char* smem) {
    const int tid = threadIdx.x, wid = tid >> 6, lane = tid & 63, nb = gridDim.x, b = blockIdx.x;
    unsigned char* ws = p.ws;
    float* tl = (float*)smem;
    float* wff = (float*)(smem + 32768);
    {
        for (int it = b; it < 32 * 176; it += nb) { const int kt = it / 176, nt = it % 176; const int n0 = nt * 64; transpose_tile(p.w_in, NIN_SRC, n0 < 3072 ? n0 : n0 + 8, (bf16_t*)(ws + OFF_WIN), 2048, kt * 64, n0, tl); }
        for (int it = b; it < 16 * 32; it += nb) { const int kt = it / 32, nt = it % 32; transpose_tile(p.w_a_up, 2048, nt * 64, (bf16_t*)(ws + OFF_WA), 1024, kt * 64, nt * 64, tl); }
        for (int it = b; it < 16 * 32; it += nb) { const int kt = it / 32, nt = it % 32; transpose_tile(p.w_b_up, 2048, nt * 64, (bf16_t*)(ws + OFF_WB), 1024, kt * 64, nt * 64, tl); }
        for (int it = b; it < 32 * 32; it += nb) { const int kt = it / 32, nt = it % 32; transpose_tile(p.w_o, 2048, nt * 64, (bf16_t*)(ws + OFF_WO), 2048, kt * 64, nt * 64, tl); }
        for (int it = b; it < 32 * 32; it += nb) { const int kt = it / 32, nt = it % 32; transpose_tile(p.peer_wq, 2048, nt * 64, (bf16_t*)(ws + OFF_WQ), 2048, kt * 64, nt * 64, tl); }
    }
    for (int i = tid; i < 2048 * 8; i += 512) { const int d = i >> 3, hh = i & 7; wff[hh * 2048 + d] = p.w_in[(size_t)d * NIN_SRC + 3072 + hh]; }
    __syncthreads();
    {
        bf16_t* h = (bf16_t*)p.out; float* logfa = (float*)(ws + OFF_LOGFA);
        for (int row = b * 8 + wid; row < T; row += nb * 8) {
            const float* xr = p.x + (size_t)row * D; f32x4 xv[8]; float ss = 0.f;
#pragma unroll
            for (int i = 0; i < 8; ++i) { xv[i] = *(const f32x4*)(xr + i * 256 + lane * 4); ss += xv[i][0] * xv[i][0] + xv[i][1] * xv[i][1] + xv[i][2] * xv[i][2] + xv[i][3] * xv[i][3]; }
            ss = wave_sum(ss); const float rs = rsqrtf(ss * (1.f / 2048.f) + EPS);
            float fa[8] = {0, 0, 0, 0, 0, 0, 0, 0};
#pragma unroll
            for (int i = 0; i < 8; ++i) {
                const f32x4 g = *(const f32x4*)(p.norm1_g + i * 256 + lane * 4);
                f32x4 hv; hv[0] = xv[i][0] * rs * g[0]; hv[1] = xv[i][1] * rs * g[1]; hv[2] = xv[i][2] * rs * g[2]; hv[3] = xv[i][3] * rs * g[3];
                u32x2 o; o[0] = cvt_pk_bf16_asm(hv[0], hv[1]); o[1] = cvt_pk_bf16_asm(hv[2], hv[3]);
                *(u32x2*)(h + (size_t)row * D + i * 256 + lane * 4) = o;
#pragma unroll
                for (int hh = 0; hh < 8; ++hh) { const f32x4 w = *(const f32x4*)(wff + hh * 2048 + i * 256 + lane * 4); fa[hh] += hv[0] * w[0] + hv[1] * w[1] + hv[2] * w[2] + hv[3] * w[3]; }
            }
#pragma unroll
            for (int hh = 0; hh < 8; ++hh) fa[hh] = wave_sum(fa[hh]);
            float mine = fa[0];
#pragma unroll
            for (int hh = 1; hh < 8; ++hh) mine = (lane == hh) ? fa[hh] : mine;
            if (lane < 8) { const float z = mine + p.fox_f_bias[lane]; logfa[(size_t)row * 8 + lane] = fminf(z, 0.f) - log1pf(__expf(-fabsf(z))); }
        }
    }
    cvt_stream(p.peer_keys, (bf16_t*)(ws + OFF_KEYS), (size_t)8 * 2 * 128 * 128);
}
__device__ void hg_local_item(const Params& p, unsigned char* smem, int item) {
    const int tid = threadIdx.x, wid = tid >> 6, lane = tid & 63, r = lane & 15, q4 = lane >> 4;
    unsigned char* ws = p.ws;
    const int c = item >> 3, h = item & 7, t0 = c * 64;
    bf16_t* qeS = (bf16_t*)smem;
    bf16_t* keS = qeS + 64 * 136;
    bf16_t* kdT = keS + 64 * 136;
    bf16_t* vT = kdT + 128 * 72;
    bf16_t* Am = vT + 128 * 72;
    float* segsum = (float*)(Am + 64 * 72);
    const float* logf = (const float*)((const unsigned char*)p.out + OUT_LOGF); const bf16_t* qin = (const bf16_t*)(ws + OFF_QIN); const bf16_t* vin = (const bf16_t*)(ws + OFF_V);
    bf16_t* qeG = (bf16_t*)(ws + OFF_QE); float* dec = (float*)(ws + OFF_DEC); float* ointra = (float*)(ws + OFF_OINTRA); bf16_t* LT = (bf16_t*)(ws + OFF_LT);
    {
        const int k = tid & 127, seg = tid >> 7;
        float lf[16], bl[16]; float run = 0.f;
        const size_t base = (size_t)(t0 + seg * 16) * 1024 + h * 128 + k;
#pragma unroll
        for (int i = 0; i < 16; ++i) { lf[i] = logf[base + (size_t)i * 1024]; run += lf[i]; bl[i] = run; }
        segsum[seg * 128 + k] = run;
        __syncthreads();
        float off = 0.f, tot = 0.f;
#pragma unroll
        for (int s = 0; s < 4; ++s) { const float v = segsum[s * 128 + k]; off += (s < seg) ? v : 0.f; tot += v; }
#pragma unroll
        for (int i = 0; i < 16; ++i) {
            const int t = seg * 16 + i; const float bb = bl[i] + off; const float kk = 1.f - __expf(lf[i]);
            const float q = bf2f(qin[base + (size_t)i * 1024]);
            const bf16_t qe = f2bf(q * __expf(bb));
            qeS[t * 136 + k] = qe; qeG[base + (size_t)i * 1024] = qe;
            keS[t * 136 + k] = f2bf(kk * __expf(-bb));
            kdT[k * 72 + t] = f2bf(kk * __expf(tot - bb));
            vT[k * 72 + t] = vin[base + (size_t)i * 1024];
        }
        if (seg == 0) dec[item * 128 + k] = __expf(tot);
    }
    __syncthreads();
    {
        const int tt = wid >> 1;
#pragma unroll
        for (int u = 0; u < 2; ++u) {
            const int st = (wid & 1) * 2 + u;
            f32x4 acc = {0.f, 0.f, 0.f, 0.f};
            if (st <= tt) {
#pragma unroll
                for (int ks = 0; ks < 4; ++ks) acc = mfma16(*(const bf16x8*)(qeS + (tt * 16 + r) * 136 + ks * 32 + q4 * 8), *(const bf16x8*)(keS + (st * 16 + r) * 136 + ks * 32 + q4 * 8), acc);
            }
#pragma unroll
            for (int j = 0; j < 4; ++j) { const int t = tt * 16 + q4 * 4 + j, s = st * 16 + r; Am[t * 72 + s] = f2bf((s <= t) ? acc[j] : 0.f); }
        }
    }
    __syncthreads();
    {
        const int tt = wid & 3;
#pragma unroll
        for (int u = 0; u < 4; ++u) {
            const int vt = (wid >> 2) * 4 + u; f32x4 acc = {0.f, 0.f, 0.f, 0.f};
#pragma unroll
            for (int ks = 0; ks < 2; ++ks) acc = mfma16(*(const bf16x8*)(vT + (vt * 16 + r) * 72 + ks * 32 + q4 * 8), *(const bf16x8*)(Am + (tt * 16 + r) * 72 + ks * 32 + q4 * 8), acc);
            *(f32x4*)(ointra + (size_t)(t0 + tt * 16 + r) * 1024 + h * 128 + vt * 16 + q4 * 4) = acc;
        }
    }
    {
        const int vt = wid;
#pragma unroll
        for (int kt = 0; kt < 8; ++kt) {
            f32x4 acc = {0.f, 0.f, 0.f, 0.f};
#pragma unroll
            for (int ks = 0; ks < 2; ++ks) acc = mfma16(*(const bf16x8*)(kdT + (kt * 16 + r) * 72 + ks * 32 + q4 * 8), *(const bf16x8*)(vT + (vt * 16 + r) * 72 + ks * 32 + q4 * 8), acc);
            u32x2 o; o[0] = cvt_pk_bf16(acc[0], acc[1]); o[1] = cvt_pk_bf16(acc[2], acc[3]);
            *(u32x2*)(LT + (size_t)item * 16384 + (vt * 16 + r) * 128 + kt * 16 + q4 * 4) = o;
        }
    }
    __syncthreads();
}
__device__ void fox_scan_item(const Params& p, unsigned char* smem, int h) {
    const int tid = threadIdx.x, wid = tid >> 6, lane = tid & 63;
    unsigned char* ws = p.ws;
    const float* logfa = (const float*)(ws + OFF_LOGFA); float* cf = (float*)(ws + OFF_CFOX) + (size_t)h * T;
    float* wtot = (float*)smem;
    float loc[16]; float run = 0.f;
#pragma unroll
    for (int i = 0; i < 16; ++i) { run += logfa[(size_t)(tid * 16 + i) * 8 + h]; loc[i] = run; }
    float inc = run;
#pragma unroll
    for (int o = 1; o < 64; o <<= 1) { const float n = __shfl_up(inc, o); if (lane >= o) inc += n; }
    if (lane == 63) wtot[wid] = inc;
    const bf16_t* fq = (const bf16_t*)(ws + OFF_FQ); const bf16_t* fk = (const bf16_t*)(ws + OFF_FK);
    float qm = 0.f, km = 0.f;
    for (int it = 0; it < 256; ++it) {
        const int row = it * 32 + wid * 4 + (lane >> 4); const size_t o = (size_t)row * 1024 + h * 128 + (lane & 15) * 8;
        const u32x4 a = *(const u32x4*)(fq + o), bq = *(const u32x4*)(fk + o); float sa = 0.f, sb = 0.f;
#pragma unroll
        for (int e = 0; e < 4; ++e) { sa += bflo(a[e]) * bflo(a[e]) + bfhi(a[e]) * bfhi(a[e]); sb += bflo(bq[e]) * bflo(bq[e]) + bfhi(bq[e]) * bfhi(bq[e]); }
#pragma unroll
        for (int o2 = 1; o2 < 16; o2 <<= 1) { sa += __shfl_xor(sa, o2); sb += __shfl_xor(sb, o2); }
        qm = fmaxf(qm, sa); km = fmaxf(km, sb);
    }
#pragma unroll
    for (int o2 = 16; o2 < 64; o2 <<= 1) { qm = fmaxf(qm, __shfl_xor(qm, o2)); km = fmaxf(km, __shfl_xor(km, o2)); }
    if (lane == 0) { wtot[8 + wid] = qm; wtot[16 + wid] = km; }
    __syncthreads();
    float off = 0.f;
#pragma unroll
    for (int w = 0; w < 8; ++w) off += (w < wid) ? wtot[w] : 0.f;
    off += inc - run;
#pragma unroll
    for (int i = 0; i < 16; ++i) cf[tid * 16 + i] = off + loc[i];
    if (tid == 0) { float a = 0.f, b2 = 0.f; for (int w = 0; w < 8; ++w) { a = fmaxf(a, wtot[8 + w]); b2 = fmaxf(b2, wtot[16 + w]); } ((float*)(ws + OFF_BQ))[h] = sqrtf(a) * sqrtf(b2) * 1.01f; }
    __syncthreads();
}
__device__ void phase_hg_local(const Params& p, unsigned char* smem) {
    for (int it = blockIdx.x; it < 8 + 1024; it += gridDim.x) { if (it < 8) fox_scan_item(p, smem, it); else hg_local_item(p, smem, it - 8); }
}
__device__ void attn_item(const Params& p, unsigned char* smem, int item) {
    const int tid = threadIdx.x, wid = tid >> 6, lane = tid & 63, r = lane & 15, q4 = lane >> 4;
    unsigned char* ws = p.ws;
    const int h = item & 7, qb = item >> 3, t0 = qb * 128, tw = t0 + wid * 16;
    bf16_t* Ks = (bf16_t*)smem;
    bf16_t* vT = Ks + 64 * 136;
    float* csS = (float*)(vT + 128 * 72);
    const bf16_t* fq = (const bf16_t*)(ws + OFF_FQ); const bf16_t* fk = (const bf16_t*)(ws + OFF_FK); const bf16_t* fv = (const bf16_t*)(ws + OFF_FV);
    const float* cf = (const float*)(ws + OFF_CFOX) + (size_t)h * T; bf16_t* ya = (bf16_t*)(ws + OFF_YA);
    bf16x8 qf[4];
#pragma unroll
    for (int ks = 0; ks < 4; ++ks) qf[ks] = *(const bf16x8*)(fq + (size_t)(tw + r) * 1024 + h * 128 + ks * 32 + q4 * 8);
    const int trow = tw + r; const float ct = cf[trow];
    const float thr = -(26.f + 2.f * ((const float*)(ws + OFF_BQ))[h]);
    const float c0 = cf[t0];
    int lo = 0, hi = 2 * qb;
    while (lo < hi) { const int mid = (lo + hi) >> 1; if (c0 - cf[mid * 64 + 63] >= thr) hi = mid; else lo = mid + 1; }
    const int j_lo = lo, j_hi = 2 * qb + 1;
    float m = -1e30f, l = 0.f;
    f32x4 O[8];
#pragma unroll
    for (int d = 0; d < 8; ++d) O[d] = (f32x4){0.f, 0.f, 0.f, 0.f};
    for (int j = j_hi; j >= j_lo; --j) {
        __syncthreads();
#pragma unroll
        for (int u = 0; u < 2; ++u) {
            const int ci = tid + u * 512, key = ci >> 4, dc = ci & 15; const size_t go = (size_t)(j * 64 + key) * 1024 + h * 128 + dc * 8;
            *(u32x4*)(Ks + key * 136 + dc * 8) = *(const u32x4*)(fk + go);
            const u32x4 vv = *(const u32x4*)(fv + go);
#pragma unroll
            for (int e = 0; e < 4; ++e) { vT[(dc * 8 + 2 * e) * 72 + key] = (bf16_t)(vv[e] & 0xffffu); vT[(dc * 8 + 2 * e + 1) * 72 + key] = (bf16_t)(vv[e] >> 16); }
        }
        if (tid < 64) csS[tid] = cf[j * 64 + tid];
        __syncthreads();
        if (j * 64 > tw + 15) continue;
        f32x4 S[4];
#pragma unroll
        for (int nt = 0; nt < 4; ++nt) { S[nt] = (f32x4){0.f, 0.f, 0.f, 0.f};
#pragma unroll
            for (int ks = 0; ks < 4; ++ks) S[nt] = mfma16(*(const bf16x8*)(Ks + (nt * 16 + r) * 136 + ks * 32 + q4 * 8), qf[ks], S[nt]); }
        float mx = -INFINITY;
#pragma unroll
        for (int nt = 0; nt < 4; ++nt)
#pragma unroll
            for (int jj = 0; jj < 4; ++jj) { const int key = nt * 16 + q4 * 4 + jj; float v = S[nt][jj] + ct - csS[key]; v = (j * 64 + key <= trow) ? v : -INFINITY; S[nt][jj] = v; mx = fmaxf(mx, v); }
        mx = fmaxf(mx, __shfl_xor(mx, 16)); mx = fmaxf(mx, __shfl_xor(mx, 32));
        const float mn = fmaxf(m, mx), alpha = __expf(m - mn); m = mn;
        float rs = 0.f;
#pragma unroll
        for (int nt = 0; nt < 4; ++nt)
#pragma unroll
            for (int jj = 0; jj < 4; ++jj) { const float pe = __expf(S[nt][jj] - mn); S[nt][jj] = pe; rs += pe; }
        rs += __shfl_xor(rs, 16); rs += __shfl_xor(rs, 32);
        l = l * alpha + rs;
#pragma unroll
        for (int d = 0; d < 8; ++d) { O[d][0] *= alpha; O[d][1] *= alpha; O[d][2] *= alpha; O[d][3] *= alpha; }
#pragma unroll
        for (int k2 = 0; k2 < 2; ++k2) {
            u32x4 pp; pp[0] = cvt_pk_bf16(S[2 * k2][0], S[2 * k2][1]); pp[1] = cvt_pk_bf16(S[2 * k2][2], S[2 * k2][3]); pp[2] = cvt_pk_bf16(S[2 * k2 + 1][0], S[2 * k2 + 1][1]); pp[3] = cvt_pk_bf16(S[2 * k2 + 1][2], S[2 * k2 + 1][3]);
            const bf16x8 pf = __builtin_bit_cast(bf16x8, pp);
#pragma unroll
            for (int d = 0; d < 8; ++d) {
                const u32x2 va = *(const u32x2*)(vT + (d * 16 + r) * 72 + (2 * k2) * 16 + q4 * 4), vb = *(const u32x2*)(vT + (d * 16 + r) * 72 + (2 * k2 + 1) * 16 + q4 * 4);
                u32x4 vv; vv[0] = va[0]; vv[1] = va[1]; vv[2] = vb[0]; vv[3] = vb[1];
                O[d] = mfma16(__builtin_bit_cast(bf16x8, vv), pf, O[d]);
            }
        }
    }
    const float il = 1.f / l;
#pragma unroll
    for (int d = 0; d < 8; ++d) { u32x2 o; o[0] = cvt_pk_bf16(O[d][0] * il, O[d][1] * il); o[1] = cvt_pk_bf16(O[d][2] * il, O[d][3] * il);
        *(u32x2*)(ya + (size_t)trow * 1024 + h * 128 + d * 16 + q4 * 4) = o; }
    __syncthreads();
}
__device__ void hg_scan_item(const Params& p, int item) {
    const int tid = threadIdx.x; unsigned char* ws = p.ws;
    const int h = item & 7, vg = item >> 3; const int v = vg * 4 + (tid >> 7), k = tid & 127;
    const bf16_t* LT = (const bf16_t*)(ws + OFF_LT); const float* dec = (const float*)(ws + OFF_DEC); bf16_t* ST = (bf16_t*)(ws + OFF_ST);
    float s = 0.f;
    for (int c0 = 0; c0 < 128; c0 += 8) {
        bf16_t lt[8]; float dd[8];
#pragma unroll
        for (int u = 0; u < 8; ++u) { const int it = (c0 + u) * 8 + h; lt[u] = LT[(size_t)it * 16384 + v * 128 + k]; dd[u] = dec[it * 128 + k]; }
#pragma unroll
        for (int u = 0; u < 8; ++u) { const int it = (c0 + u) * 8 + h; ST[(size_t)it * 16384 + v * 128 + k] = f2bf(s); s = dd[u] * s + bf2f(lt[u]); }
    }
}
__device__ void phase_attn_scan(const Params& p, unsigned char* smem) {
    for (int it = blockIdx.x; it < 256 + 512; it += gridDim.x) { if (it < 256) hg_scan_item(p, it); else attn_item(p, smem, it - 256); }
}
__device__ void phase_hg_out(const Params& p) {
    const int tid = threadIdx.x, wid = tid >> 6, lane = tid & 63, r = lane & 15, q4 = lane >> 4;
    unsigned char* ws = p.ws;
    const bf16_t* qe = (const bf16_t*)(ws + OFF_QE); const bf16_t* ST = (const bf16_t*)(ws + OFF_ST); const float* ointra = (const float*)(ws + OFF_OINTRA);
    const bf16_t* sgate = (const bf16_t*)(ws + OFF_SGATE); bf16_t* ob = (bf16_t*)(ws + OFF_OB);
    for (int wt = blockIdx.x * 8 + wid; wt < 4096; wt += gridDim.x * 8) {
        const int item = wt >> 2, tt = wt & 3, c = item >> 3, h = item & 7; const int t = c * 64 + tt * 16 + r;
        bf16x8 qf[4];
#pragma unroll
        for (int ks = 0; ks < 4; ++ks) qf[ks] = *(const bf16x8*)(qe + (size_t)t * 1024 + h * 128 + ks * 32 + q4 * 8);
        f32x4 o[8]; float ss = 0.f;
#pragma unroll
        for (int vt = 0; vt < 8; ++vt) {
            f32x4 acc = *(const f32x4*)(ointra + (size_t)t * 1024 + h * 128 + vt * 16 + q4 * 4);
#pragma unroll
            for (int ks = 0; ks < 4; ++ks) acc = mfma16(*(const bf16x8*)(ST + (size_t)item * 16384 + (vt * 16 + r) * 128 + ks * 32 + q4 * 8), qf[ks], acc);
            o[vt] = acc; ss += acc[0] * acc[0] + acc[1] * acc[1] + acc[2] * acc[2] + acc[3] * acc[3];
        }
        ss += __shfl_xor(ss, 16); ss += __shfl_xor(ss, 32);
        const float rs = rsqrtf(ss * (1.f / 128.f) + EPS);
#pragma unroll
        for (int vt = 0; vt < 8; ++vt) {
            const int col = h * 128 + vt * 16 + q4 * 4; const f32x4 g = *(const f32x4*)(p.hg_norm_g + col); const u32x2 sg = *(const u32x2*)(sgate + (size_t)t * 1024 + col);
            u32x2 w; w[0] = cvt_pk_bf16(o[vt][0] * rs * g[0] * bflo(sg[0]), o[vt][1] * rs * g[1] * bfhi(sg[0])); w[1] = cvt_pk_bf16(o[vt][2] * rs * g[2] * bflo(sg[1]), o[vt][3] * rs * g[3] * bfhi(sg[1]));
            *(u32x2*)(ob + (size_t)t * 1024 + col) = w;
        }
    }
}
__device__ void phase_route(const Params& p, unsigned char* smem) {
    const int tid = threadIdx.x, wid = tid >> 6, lane = tid & 63, r = lane & 15, q4 = lane >> 4;
    unsigned char* ws = p.ws;
    const bf16_t* qp = (const bf16_t*)(ws + OFF_QP); const bf16_t* keys = (const bf16_t*)(ws + OFF_KEYS);
    int* idxo = (int*)(ws + OFF_IDX); float* gateo = (float*)(ws + OFF_GATE);
    float* sc = (float*)smem;
    float* top = sc + 128 * 129;
    for (int item = blockIdx.x; item < 128 * 8; item += gridDim.x) {
        const int h = item & 7, t0 = (item >> 3) * 64;
        {
            const int c = wid >> 2, tt = wid & 3;
            bf16x8 af[4];
#pragma unroll
            for (int ks = 0; ks < 4; ++ks) af[ks] = *(const bf16x8*)(qp + (size_t)(t0 + tt * 16 + r) * 2048 + h * 256 + c * 128 + ks * 32 + q4 * 8);
#pragma unroll
            for (int nt = 0; nt < 8; ++nt) {
                f32x4 acc = {0.f, 0.f, 0.f, 0.f};
#pragma unroll
                for (int ks = 0; ks < 4; ++ks) acc = mfma16(af[ks], *(const bf16x8*)(keys + (size_t)((h * 2 + c) * 128 + nt * 16 + r) * 128 + ks * 32 + q4 * 8), acc);
#pragma unroll
                for (int jj = 0; jj < 4; ++jj) sc[(c * 64 + tt * 16 + q4 * 4 + jj) * 129 + nt * 16 + r] = acc[jj];
            }
        }
        __syncthreads();
        if (tid < 128) {
            float lst[16];
#pragma unroll
            for (int i = 0; i < 16; ++i) lst[i] = -INFINITY;
            const float* row = sc + tid * 129;
#pragma unroll 4
            for (int n = 0; n < 128; ++n) {
                float x = __uint_as_float((__float_as_uint(row[n]) & ~127u) | (unsigned)n);
#pragma unroll
                for (int i = 0; i < 16; ++i) { const float hi = fmaxf(lst[i], x); x = fminf(lst[i], x); lst[i] = hi; }
            }
#pragma unroll
            for (int i = 0; i < 16; ++i) top[tid * 17 + i] = lst[i];
        }
        __syncthreads();
        if (tid < 64) {
            float a[16], bb[16], best[16];
#pragma unroll
            for (int i = 0; i < 16; ++i) { a[i] = top[tid * 17 + i]; bb[i] = top[(64 + tid) * 17 + i]; best[i] = -INFINITY; }
#pragma unroll
            for (int i = 0; i < 16; ++i)
#pragma unroll
                for (int j = 0; j < 16; ++j) if ((i + 1) * (j + 1) <= 16) {
                    float x = __uint_as_float((__float_as_uint(a[i] + bb[j]) & ~255u) | (unsigned)(i * 16 + j));
#pragma unroll
                    for (int k = 0; k < 16; ++k) { const float hi = fmaxf(best[k], x); x = fminf(best[k], x); best[k] = hi; }
                }
            float e[16], sum = 0.f;
#pragma unroll
            for (int k = 0; k < 16; ++k) { e[k] = __expf(best[k] - best[0]); sum += e[k]; }
            const float inv = 1.f / sum; const size_t ob = (size_t)(t0 + tid) * 128 + h * 16;
#pragma unroll
            for (int k = 0; k < 16; ++k) {
                const unsigned pos = __float_as_uint(best[k]) & 255u; const int i = pos >> 4, j = pos & 15;
                const int i0 = (int)(__float_as_uint(top[tid * 17 + i]) & 127u), i1 = (int)(__float_as_uint(top[(64 + tid) * 17 + j]) & 127u);
                idxo[ob + k] = i0 * 128 + i1; gateo[ob + k] = e[k] * inv;
            }
        }
        __syncthreads();
    }
}
__device__ __forceinline__ float gelu_tanh(float x) { const float u = 0.7978845608028654f * (x + 0.044715f * x * x * x); const float t = 1.f - 2.f / (1.f + __expf(2.f * u)); return 0.5f * x * (1.f + t); }
__device__ void phase_peer(const Params& p) {
    const int tid = threadIdx.x, wid = tid >> 6, lane = tid & 63;
    unsigned char* ws = p.ws;
    const bf16_t* xg2 = (const bf16_t*)(ws + OFF_XG2); const float* sumsq = (const float*)(ws + OFF_SUMSQ);
    const int* idx = (const int*)(ws + OFF_IDX); const float* gate = (const float*)(ws + OFF_GATE);
    const bf16_t* Ub = (const bf16_t*)(ws + OFF_UBF); const bf16_t* Vb = (const bf16_t*)(ws + OFF_VBF);
    for (int t = blockIdx.x * 8 + wid; t < T; t += gridDim.x * 8) {
        const int tu = __builtin_amdgcn_readfirstlane(t);
        const float rs = row_rstd(sumsq, tu);
        float xv[32];
#pragma unroll
        for (int i = 0; i < 4; ++i) { const u32x4 a = *(const u32x4*)(xg2 + (size_t)tu * 2048 + i * 512 + lane * 8);
#pragma unroll
            for (int e = 0; e < 4; ++e) { xv[i * 8 + 2 * e] = bflo(a[e]) * rs; xv[i * 8 + 2 * e + 1] = bfhi(a[e]) * rs; } }
        float w0 = 0.f, w1 = 0.f;
        for (int j0 = 0; j0 < 128; j0 += 4) {
            float d[4];
#pragma unroll
            for (int u = 0; u < 4; ++u) {
                const int e = idx[(size_t)tu * 128 + j0 + u]; const bf16_t* ur = Ub + (size_t)e * 2048 + lane * 8; float s = 0.f;
#pragma unroll
                for (int i = 0; i < 4; ++i) { const u32x4 a = *(const u32x4*)(ur + i * 512);
#pragma unroll
                    for (int q = 0; q < 4; ++q) s += bflo(a[q]) * xv[i * 8 + 2 * q] + bfhi(a[q]) * xv[i * 8 + 2 * q + 1]; }
                d[u] = s;
            }
#pragma unroll
            for (int u = 0; u < 4; ++u) { const float s = wave_sum(d[u]); const int j = j0 + u; if (j < 64) w0 = (lane == j) ? s : w0; else w1 = (lane == j - 64) ? s : w1; }
        }
        w0 = gelu_tanh(w0) * gate[(size_t)tu * 128 + lane]; w1 = gelu_tanh(w1) * gate[(size_t)tu * 128 + 64 + lane];
        float acc[32];
#pragma unroll
        for (int i = 0; i < 32; ++i) acc[i] = 0.f;
        for (int j0 = 0; j0 < 128; j0 += 4) {
#pragma unroll
            for (int u = 0; u < 4; ++u) {
                const int j = j0 + u; const int e = idx[(size_t)tu * 128 + j]; const float w = __shfl(j < 64 ? w0 : w1, j & 63);
                const bf16_t* vr = Vb + (size_t)e * 2048 + lane * 8;
#pragma unroll
                for (int i = 0; i < 4; ++i) { const u32x4 a = *(const u32x4*)(vr + i * 512);
#pragma unroll
                    for (int q = 0; q < 4; ++q) { acc[i * 8 + 2 * q] += w * bflo(a[q]); acc[i * 8 + 2 * q + 1] += w * bfhi(a[q]); } }
            }
        }
        float* orow = p.out + (size_t)tu * 2048; float ss = 0.f;
#pragma unroll
        for (int i = 0; i < 4; ++i) { const f32x4 a = *(const f32x4*)(orow + i * 512 + lane * 8), b = *(const f32x4*)(orow + i * 512 + lane * 8 + 4);
#pragma unroll
            for (int e = 0; e < 4; ++e) { acc[i * 8 + e] += a[e]; acc[i * 8 + 4 + e] += b[e]; }
#pragma unroll
            for (int e = 0; e < 8; ++e) ss += acc[i * 8 + e] * acc[i * 8 + e]; }
        ss = wave_sum(ss); const float rf = rsqrtf(ss * (1.f / 2048.f) + EPS);
#pragma unroll
        for (int i = 0; i < 4; ++i) { const f32x4 ga = *(const f32x4*)(p.norm_f_g + i * 512 + lane * 8), gb = *(const f32x4*)(p.norm_f_g + i * 512 + lane * 8 + 4);
            f32x4 oa, ob2;
#pragma unroll
            for (int e = 0; e < 4; ++e) { oa[e] = acc[i * 8 + e] * rf * ga[e]; ob2[e] = acc[i * 8 + 4 + e] * rf * gb[e]; }
            *(f32x4*)(orow + i * 512 + lane * 8) = oa; *(f32x4*)(orow + i * 512 + lane * 8 + 4) = ob2; }
    }
}

#ifndef DBG_STOP
#define DBG_STOP 0
#endif
__device__ void dbg_dump(const Params& p, const void* A, int a_f32, const void* B, int b_f32) {
    for (size_t i = (size_t)blockIdx.x * 512 + threadIdx.x; i < (size_t)T * 2048; i += (size_t)gridDim.x * 512) {
        const size_t t = i >> 11; const int c = (int)(i & 2047); const void* S = c < 1024 ? A : B; const int f = c < 1024 ? a_f32 : b_f32; const size_t o = t * 1024 + (c & 1023);
        p.out[i] = f ? ((const float*)S)[o] : bf2f(((const bf16_t*)S)[o]);
    }
}
__global__ void __launch_bounds__(512, 2) fwd_megakernel(Params p) {
    extern __shared__ __attribute__((aligned(16))) unsigned char smem[];
    cg::grid_group grid = cg::this_grid();
#define GSYNC() do { __builtin_amdgcn_fence(__ATOMIC_RELEASE, "agent"); grid.sync(); __builtin_amdgcn_fence(__ATOMIC_ACQUIRE, "agent"); } while (0)
    unsigned char* ws = p.ws;
    phase_prep(p, smem);
    GSYNC();
    {
        FZ f; f.fq = (bf16_t*)(ws + OFF_FQ); f.fk = (bf16_t*)(ws + OFF_FK); f.fv = (bf16_t*)(ws + OFF_FV); f.qin = (bf16_t*)(ws + OFF_QIN); f.v = (bf16_t*)(ws + OFF_V);
        f.sgate = (bf16_t*)(ws + OFF_SGATE); f.sga = (bf16_t*)(ws + OFF_SGA); f.sgb = (bf16_t*)(ws + OFF_SGB); f.logfo = (float*)((unsigned char*)p.out + OUT_LOGF); f.lbl = p.hg_lb_logits;
        run_gemm(smem, (const bf16_t*)p.out, (const bf16_t*)(ws + OFF_WIN), T, NZ, 2048, f);
    }
    GSYNC();
    phase_hg_local(p, smem);
    GSYNC();
    phase_attn_scan(p, smem);
    GSYNC();
    if (DBG_STOP == 3) { dbg_dump(p, ws + OFF_YA, 0, ws + OFF_ST, 0); return; }
    phase_hg_out(p);
    GSYNC();
    if (DBG_STOP == 4) { dbg_dump(p, ws + OFF_YA, 0, ws + OFF_OB, 0); return; }
    {
        FA fa; fa.merged = (bf16_t*)(ws + OFF_MERGED); fa.sg = (const bf16_t*)(ws + OFF_SGA);
        run_gemm(smem, (const bf16_t*)(ws + OFF_YA), (const bf16_t*)(ws + OFF_WA), T, 2048, 1024, fa);
        FB fb; fb.merged = (bf16_t*)(ws + OFF_MERGED); fb.sg = (const bf16_t*)(ws + OFF_SGB);
        run_gemm(smem, (const bf16_t*)(ws + OFF_OB), (const bf16_t*)(ws + OFF_WB), T, 2048, 1024, fb);
    }
    GSYNC();
    {
        FO f; f.x = p.x; f.g2 = p.norm2_g; f.x1 = p.out; f.xg2 = (bf16_t*)(ws + OFF_XG2); f.sumsq = (float*)(ws + OFF_SUMSQ);
        run_gemm(smem, (const bf16_t*)(ws + OFF_MERGED), (const bf16_t*)(ws + OFF_WO), T, 2048, 2048, f);
    }
    GSYNC();
    if (DBG_STOP == 6) { dbg_dump(p, ws + OFF_XG2, 0, ws + OFF_MERGED, 0); return; }
    {
        FQ f; f.qp = (bf16_t*)(ws + OFF_QP); f.sumsq = (const float*)(ws + OFF_SUMSQ);
        run_gemm(smem, (const bf16_t*)(ws + OFF_XG2), (const bf16_t*)(ws + OFF_WQ), T, 2048, 2048, f);
    }
    GSYNC();
    if (DBG_STOP == 8) { dbg_dump(p, ws + OFF_QP, 0, ws + OFF_QP + 16 * MiB, 0); return; }
    phase_route(p, smem);
    cvt_stream(p.peer_u, (bf16_t*)(ws + OFF_UBF), (size_t)16384 * 2048);
    cvt_stream(p.peer_v, (bf16_t*)(ws + OFF_VBF), (size_t)16384 * 2048);
    GSYNC();
    phase_peer(p);
}

extern "C" void kernel_launch(void* const* d_in, const int* in_sizes, int n_in, void* d_out, int out_size, void* d_ws, size_t ws_size, hipStream_t stream) {
    static int grid_blocks = 0;
    if (!grid_blocks) {
        int dev = 0, cus = 0, per_cu = 0;
        (void)hipGetDevice(&dev);
        (void)hipDeviceGetAttribute(&cus, hipDeviceAttributeMultiprocessorCount, dev);
        (void)hipFuncSetAttribute((const void*)fwd_megakernel, hipFuncAttributeMaxDynamicSharedMemorySize, LDS_BYTES);
        (void)hipOccupancyMaxActiveBlocksPerMultiprocessor(&per_cu, (const void*)fwd_megakernel, 512, LDS_BYTES);
        if (per_cu < 1) per_cu = 1;
        grid_blocks = cus * per_cu;
        if (ws_size < WS_END) fprintf(stderr, "kernel_launch: workspace too small (%zu < %zu)\n", ws_size, (size_t)WS_END);
    }
    Params p{};
    p.x = (const float*)d_in[0]; p.norm1_g = (const float*)d_in[1]; p.w_in = (const float*)d_in[2]; p.fox_f_bias = (const float*)d_in[3]; p.hg_lb_logits = (const float*)d_in[4];
    p.hg_norm_g = (const float*)d_in[5]; p.w_a_up = (const float*)d_in[6]; p.w_b_up = (const float*)d_in[7]; p.w_o = (const float*)d_in[8]; p.norm2_g = (const float*)d_in[9];
    p.peer_wq = (const float*)d_in[10]; p.peer_keys = (const float*)d_in[11]; p.peer_u = (const float*)d_in[12]; p.peer_v = (const float*)d_in[13]; p.norm_f_g = (const float*)d_in[14];
    p.out = (float*)d_out; p.ws = (unsigned char*)d_ws;
    void* args[] = {&p};
    hipError_t e = hipLaunchCooperativeKernel((const void*)fwd_megakernel, dim3(grid_blocks), dim3(512), args, LDS_BYTES, stream);
    if (e != hipSuccess) fprintf(stderr, "cooperative launch failed: %s (grid %d)\n", hipGetErrorString(e), grid_blocks);
}
```

```cpp
#include <hip/hip_runtime.h>
#include <hip/hip_cooperative_groups.h>
#include <cstdio>
namespace cg = cooperative_groups;
#define PG8_LAS __attribute__((address_space(3)))
typedef unsigned short bf16_t;
typedef short bf16x8 __attribute__((ext_vector_type(8)));
typedef float f32x4 __attribute__((ext_vector_type(4)));
typedef unsigned u32x4 __attribute__((ext_vector_type(4)));
constexpr int BM = 256, BK = 64, HALF = 128, HTB = HALF * BK * 2  , STAGE_BYTES = 8 * HTB, NXCD = 8, WGM = 8;

__host__ __device__ __forceinline__ int lds_byte(int r, int c) { const int st = (r >> 4) * 2 + (c >> 5), rr = r & 15, cc = c & 31, ob = rr * 64 + cc * 2; return st * 1024 + (ob ^ (((ob >> 9) & 1) << 5)); }
__host__ __device__ __forceinline__ void stage_rc(int b, int& R, int& C) { const int st = b / 1024, sb = b % 1024, swz = sb ^ (((sb >> 9) & 1) << 5); R = (st >> 1) * 16 + swz / 64; C = (st & 1) * 32 + (swz % 64) / 2; }
__host__ __device__ __forceinline__ int perm32(int rho) { const int n = rho >> 4, i = rho & 15; return 8 * (i >> 2) + 4 * n + (i & 3); }

struct Unit { int pm, pn; };
struct Gemm { const bf16_t* A; const bf16_t* Bt; int M, N, K; };

struct StaticOrder {
    int nM, nN, nwg, G, c;
    __host__ __device__ void init(int M, int N, int G_, int c_) { nM = M / BM; nN = N / BM; nwg = nM * nN; G = G_; c = c_; }
    __host__ __device__ bool next(int i, Unit& u) const {
        const long L = (long)i * G + c; if (L >= nwg) return false;
        int wgid = (int)L; { const int q = nwg / NXCD, r = nwg % NXCD, xcd = wgid % NXCD, off = wgid / NXCD; wgid = (xcd < r ? xcd * (q + 1) : r * (q + 1) + (xcd - r) * q) + off; }
        const int nig = WGM * nN, gid = wgid / nig, fm = gid * WGM, gsz = (nM - fm) < WGM ? (nM - fm) : WGM;
        u.pm = fm + ((wgid % nig) % gsz); u.pn = (wgid % nig) / gsz; return true;
    }
    __device__ __forceinline__ void a_ready(const Unit&) const {}
    __device__ __forceinline__ void done(const Unit&) const {}
};
typedef __bf16 bf16x2_t __attribute__((ext_vector_type(2)));
typedef float f32x2_t __attribute__((ext_vector_type(2)));
__device__ __forceinline__ unsigned cvt_pk_bf16(float lo, float hi) { f32x2_t v = {lo, hi}; bf16x2_t r = __builtin_convertvector(v, bf16x2_t); return __builtin_bit_cast(unsigned, r); }
template <class Epi, class Sched>
__device__ __forceinline__ void gemm_phase(PG8_LAS unsigned char* lds, const Gemm g, const Sched& S, const Epi& E) {
    const int tid = threadIdx.x, wid = __builtin_amdgcn_readfirstlane(tid >> 6), lane = tid & 63, wr = wid >> 2, wc = wid & 3, fr = lane & 15, fq = lane >> 4;
    const int K = g.K, nt = K / BK;
    unsigned voffA[2], voffB[2];
#pragma unroll
    for (int i = 0; i < 2; ++i) { int R, C; stage_rc(tid * 16 + i * 8192, R, C); const int Rb = Epi::PERM ? ((R & ~31) + perm32(R & 31)) : R;
        voffA[i] = (unsigned)(R * K + C) * 2u; voffB[i] = (unsigned)(Rb * K + C) * 2u; }
    const size_t kstep = (size_t)(BK * 2);
    const size_t hstep = (size_t)HALF * K * 2;
    const size_t tstep = 2 * hstep;
    const unsigned ldsw = (unsigned)wid * 1024u;
    const int aoff = lds_byte(wr * 64 + fr, fq * 8), boff = lds_byte(wc * 32 + fr, fq * 8);
#define PG8_SA(b, h) (((b) * 2 + (h)) * HTB)
#define PG8_SB(b, h) ((4 + (b) * 2 + (h)) * HTB)
#define PG8_STAGE(bufoff, gbase, voff) do { _Pragma("unroll") for (int _i = 0; _i < 2; ++_i) \
        __builtin_amdgcn_global_load_lds((const unsigned*)((const char*)(gbase) + (voff)[_i]), (PG8_LAS unsigned*)(lds + (bufoff) + ldsw + _i * 8192), 16, 0, 0); } while (0)
#define PG8_LDA(dst, b, h) do { _Pragma("unroll") for (int m = 0; m < 4; ++m) _Pragma("unroll") for (int k = 0; k < 2; ++k) dst[m][k] = *(const PG8_LAS bf16x8*)(lds + PG8_SA(b, h) + aoff + m * 2048 + k * 1024); } while (0)
#define PG8_LDB(dst, b, h) do { _Pragma("unroll") for (int n = 0; n < 2; ++n) _Pragma("unroll") for (int k = 0; k < 2; ++k) dst[n][k] = *(const PG8_LAS bf16x8*)(lds + PG8_SB(b, h) + boff + n * 2048 + k * 1024); } while (0)
#define PG8_MMA(ai, bj, At, Bt) do { __builtin_amdgcn_s_setprio(1); _Pragma("unroll") for (int m = 0; m < 4; ++m) _Pragma("unroll") for (int n = 0; n < 2; ++n) _Pragma("unroll") for (int k = 0; k < 2; ++k) \
        acc[ai][bj][m][n] = __builtin_amdgcn_mfma_f32_16x16x32_bf16(Bt[n][k], At[m][k], acc[ai][bj][m][n], 0, 0, 0); __builtin_amdgcn_s_setprio(0); } while (0)
#define PG8_WAIT_V(n) asm volatile("s_waitcnt vmcnt(" #n ")" ::: "memory")
#define PG8_WAIT_L(n) asm volatile("s_waitcnt lgkmcnt(" #n ")" ::: "memory")
#define PG8_BAR __builtin_amdgcn_s_barrier()
#define PG8_SCHED __builtin_amdgcn_sched_barrier(0)
    Unit cur, nxt; int ui = 0;
    if (!S.next(0, cur)) return;
    f32x4 acc[2][2][4][2];
#pragma unroll
    for (int a = 0; a < 2; ++a)
#pragma unroll
        for (int b = 0; b < 2; ++b)
#pragma unroll
            for (int m = 0; m < 4; ++m)
#pragma unroll
                for (int n = 0; n < 2; ++n) acc[a][b][m][n] = (f32x4){0.f, 0.f, 0.f, 0.f};
    bf16x8 At[4][2], B0[2][2], B1[2][2];
    const char* cA = (const char*)g.A + (size_t)cur.pm * tstep; const char* cB = (const char*)g.Bt + (size_t)cur.pn * tstep;
    S.a_ready(cur);
    PG8_STAGE(PG8_SB(0, 0), cB, voffB); PG8_STAGE(PG8_SA(0, 0), cA, voffA); PG8_STAGE(PG8_SB(0, 1), cB + hstep, voffB); PG8_STAGE(PG8_SA(0, 1), cA + hstep, voffA);
    if (wr == 1) PG8_BAR;
    PG8_WAIT_V(4); PG8_BAR;
    PG8_STAGE(PG8_SB(1, 0), cB + kstep, voffB); PG8_STAGE(PG8_SA(1, 0), cA + kstep, voffA); PG8_STAGE(PG8_SB(1, 1), cB + hstep + kstep, voffB);
    PG8_WAIT_V(6); PG8_BAR;
    for (;;) {
        const bool has_next = S.next(ui + 1, nxt);
        const char* nA = has_next ? (const char*)g.A + (size_t)nxt.pm * tstep : cA; const char* nB = has_next ? (const char*)g.Bt + (size_t)nxt.pn * tstep : cB;
        for (int t = 0; t < nt; t += 2) {
            const bool last = (t == nt - 2);
            const char* a1 = cA + (size_t)(t + 1) * kstep;
            const char* a2 = last ? nA : cA + (size_t)(t + 2) * kstep; const char* b2 = last ? nB : cB + (size_t)(t + 2) * kstep;
            const char* a3 = a2 + kstep; const char* b3 = b2 + kstep;
            if (last && has_next) S.a_ready(nxt);
            PG8_LDB(B0, 0, 0); PG8_SCHED; PG8_LDA(At, 0, 0); PG8_STAGE(PG8_SA(1, 1), a1 + hstep, voffA);
            PG8_WAIT_L(8); PG8_BAR; PG8_WAIT_L(0); PG8_MMA(0, 0, At, B0); PG8_BAR; PG8_SCHED;
            PG8_LDB(B1, 0, 1); PG8_STAGE(PG8_SB(0, 0), b2, voffB);
            PG8_BAR; PG8_WAIT_L(0); PG8_MMA(0, 1, At, B1); PG8_BAR;
            PG8_LDA(At, 0, 1); PG8_STAGE(PG8_SA(0, 0), a2, voffA);
            PG8_BAR; PG8_WAIT_L(0); PG8_MMA(1, 0, At, B0); PG8_BAR; PG8_SCHED;
            PG8_STAGE(PG8_SB(0, 1), b2 + hstep, voffB);
            PG8_WAIT_V(6); PG8_BAR; PG8_MMA(1, 1, At, B1); PG8_BAR;
            PG8_LDB(B0, 1, 0); PG8_SCHED; PG8_LDA(At, 1, 0); PG8_STAGE(PG8_SA(0, 1), a2 + hstep, voffA);
            PG8_WAIT_L(8); PG8_BAR; PG8_WAIT_L(0); PG8_MMA(0, 0, At, B0); PG8_BAR; PG8_SCHED;
            PG8_LDB(B1, 1, 1); PG8_STAGE(PG8_SB(1, 0), b3, voffB);
            PG8_BAR; PG8_WAIT_L(0); PG8_MMA(0, 1, At, B1); PG8_BAR;
            PG8_LDA(At, 1, 1); PG8_STAGE(PG8_SA(1, 0), a3, voffA);
            PG8_BAR; PG8_WAIT_L(0); PG8_MMA(1, 0, At, B0); PG8_BAR; PG8_SCHED;
            PG8_STAGE(PG8_SB(1, 1), b3 + hstep, voffB);
            PG8_WAIT_V(6); PG8_BAR; PG8_MMA(1, 1, At, B1); PG8_BAR;
        }
        if constexpr (!Epi::AFTER_DRAIN) { E(acc, cur, wr, wc, fr, fq); S.done(cur); }
        if (!has_next) break;
#pragma unroll
        for (int a = 0; a < 2; ++a)
#pragma unroll
            for (int b = 0; b < 2; ++b)
#pragma unroll
                for (int m = 0; m < 4; ++m)
#pragma unroll
                    for (int n = 0; n < 2; ++n) acc[a][b][m][n] = (f32x4){0.f, 0.f, 0.f, 0.f};
        cur = nxt; cA = nA; cB = nB; ++ui;
    }
    PG8_WAIT_V(0);
    if (wr == 0) PG8_BAR;
    PG8_BAR;
    if constexpr (Epi::AFTER_DRAIN) { E.fused(acc, cur, wr, wc, fr, fq, lds, wid, lane); S.done(cur); }
#undef PG8_SA
#undef PG8_SB
#undef PG8_STAGE
#undef PG8_LDA
#undef PG8_LDB
#undef PG8_MMA
#undef PG8_WAIT_V
#undef PG8_WAIT_L
#undef PG8_BAR
#undef PG8_SCHED
}
#define LAS PG8_LAS
typedef unsigned u32x2 __attribute__((ext_vector_type(2)));
typedef float f32x2 __attribute__((ext_vector_type(2)));

constexpr int T = 8192, D = 2048, NZ = 11264, NIN_SRC = 11272;
constexpr float EPS = 1e-6f;
constexpr size_t MiB = 1ull << 20;
constexpr size_t OFF_WIN = 0;
constexpr size_t OFF_QIN = 44 * MiB;
constexpr size_t OFF_V = 60 * MiB;
constexpr size_t OFF_FQ = 76 * MiB, OFF_FK = 92 * MiB, OFF_FV = 108 * MiB;
constexpr size_t OFF_LT = 124 * MiB;
constexpr size_t OFF_WA = 156 * MiB;
constexpr size_t OFF_WB = 160 * MiB;
constexpr size_t OFF_WO = 164 * MiB;
constexpr size_t OFF_WQ = 172 * MiB;
constexpr size_t OFF_KEYS = 180 * MiB;
constexpr size_t OFF_LOGFA = 180 * MiB + 512 * 1024;
constexpr size_t OFF_CFOX = OFF_LOGFA + 256 * 1024;
constexpr size_t OFF_BQ = OFF_CFOX + 256 * 1024;
constexpr size_t OFF_DEC = OFF_BQ + 1024;
constexpr size_t OFF_USC = 181 * MiB + 768 * 1024;
constexpr size_t OFF_VSC = 181 * MiB + 832 * 1024;
constexpr size_t OFF_BAR = 181 * MiB + 896 * 1024;
constexpr size_t BAR_BYTES = 8192;
constexpr size_t OFF_NM = 181 * MiB + 904 * 1024;
constexpr size_t OFF_SUMSQ = 182 * MiB;
constexpr size_t OFF_SGATE = 183 * MiB;
constexpr size_t OFF_SGA = 199 * MiB;
constexpr size_t OFF_SGB = 215 * MiB;
constexpr size_t OFF_V8 = 231 * MiB;
constexpr size_t OFF_ST = 263 * MiB;
constexpr size_t OFF_OINTRA = 295 * MiB;
constexpr size_t OFF_QE = 327 * MiB;
constexpr size_t OFF_YA = 343 * MiB;
constexpr size_t OFF_OB = 359 * MiB;
constexpr size_t OFF_MERGED = 375 * MiB;
constexpr size_t OFF_XG2 = 407 * MiB;
constexpr size_t OFF_QP = 439 * MiB;
constexpr size_t OFF_IDX = 471 * MiB;
constexpr size_t OFF_GATE = 475 * MiB;
constexpr size_t OFF_U8 = 479 * MiB;
constexpr size_t WS_END = 511 * MiB;
constexpr size_t OUT_LOGF = 32 * MiB;
constexpr int LDS_BYTES = 131072;

struct Params {
    const float *x, *norm1_g, *w_in, *fox_f_bias, *hg_lb_logits, *hg_norm_g, *w_a_up, *w_b_up, *w_o, *norm2_g, *peer_wq, *peer_keys, *peer_u, *peer_v, *norm_f_g;
    float* out; unsigned char* ws;
};

__device__ __forceinline__ float bf2f(bf16_t b) { return __uint_as_float(((unsigned)b) << 16); }
__device__ __forceinline__ float bflo(unsigned u) { return __uint_as_float(u << 16); }
__device__ __forceinline__ float bfhi(unsigned u) { return __uint_as_float(u & 0xffff0000u); }
__device__ __forceinline__ bf16_t f2bf(float f) { return (bf16_t)(cvt_pk_bf16(f, 0.f) & 0xffffu); }
__device__ __forceinline__ float wave_sum(float v) {
#pragma unroll
    for (int o = 32; o > 0; o >>= 1) v += __shfl_xor(v, o);
    return v;
}
__device__ __forceinline__ float sigmoidf_(float x) { return 1.f / (1.f + __expf(-x)); }
__device__ __forceinline__ float siluf_(float x) { return x / (1.f + __expf(-x)); }
__device__ __forceinline__ f32x4 mfma16(bf16x8 a, bf16x8 b, f32x4 c) { return __builtin_amdgcn_mfma_f32_16x16x32_bf16(a, b, c, 0, 0, 0); }
__device__ __forceinline__ unsigned cvt_pk_bf16_asm(float lo, float hi) { unsigned r; asm volatile("v_cvt_pk_bf16_f32 %0, %1, %2" : "=v"(r) : "v"(lo), "v"(hi)); return r; }
__device__ __forceinline__ u32x4 pack8(const float* v) { u32x4 o; o[0] = cvt_pk_bf16_asm(v[0], v[1]); o[1] = cvt_pk_bf16_asm(v[2], v[3]); o[2] = cvt_pk_bf16_asm(v[4], v[5]); o[3] = cvt_pk_bf16_asm(v[6], v[7]); return o; }

__device__ __forceinline__ float row_rstd(const float* ssp, int row) {
    const f32x4* q = (const f32x4*)(ssp + (size_t)row * 32); float s = 0.f;
#pragma unroll
    for (int i = 0; i < 8; ++i) { const f32x4 v = q[i]; s += (v[0] + v[1]) + (v[2] + v[3]); }
    return rsqrtf(s * (1.f / 2048.f) + EPS);
}
template <class F> struct EpiRow {
    static constexpr bool PERM = true, AFTER_DRAIN = false;
    F f;
    __device__ __forceinline__ void operator()(const f32x4 (&acc)[2][2][4][2], const Unit& u, int wr, int wc, int fr, int fq) const {
        const int row0 = u.pm * BM + wr * 64 + fr, col0 = u.pn * BM + wc * 32 + 8 * fq;
        asm volatile("s_nop 15\n\ts_nop 15" ::: "memory");
#pragma unroll
        for (int ai = 0; ai < 2; ++ai)
#pragma unroll
            for (int m = 0; m < 4; ++m) {
                const int row = row0 + ai * HALF + m * 16;
                float v[2][8];
#pragma unroll
                for (int bj = 0; bj < 2; ++bj)
#pragma unroll
                    for (int e = 0; e < 4; ++e) { v[bj][e] = acc[ai][bj][m][0][e]; v[bj][4 + e] = acc[ai][bj][m][1][e]; }
                f(row, col0, v[0], col0 + HALF, v[1], u);
            }
    }
};
__device__ __forceinline__ void st8bf(bf16_t* p, const float* v) { *(u32x4*)p = pack8(v); }

struct FZ {
    bf16_t *fq, *fk, *fv, *qin, *v, *sgate; unsigned char *sga, *sgb; float* logfo; const float* lbl;
    __device__ __forceinline__ void one(int row, int c, const float* a) const {
        const int reg = c >> 10, lc = c & 1023; float o[8];
        const size_t r1 = (size_t)row * 1024 + lc;
        if (reg == 0) {
#pragma unroll
            for (int e = 0; e < 8; ++e) o[e] = a[e] * 0.08838834764831845f;
            st8bf(fq + r1, o);
        } else if (reg == 1) { st8bf(fk + r1, a);
        } else if (reg == 2) { st8bf(fv + r1, a);
        } else if (reg == 3) {
#pragma unroll
            for (int e = 0; e < 8; ++e) o[e] = siluf_(a[e]);
            st8bf(qin + r1, o);
        } else if (reg == 4) {
            const f32x4 l0a = *(const f32x4*)(lbl + lc), l0b = *(const f32x4*)(lbl + lc + 4), l1a = *(const f32x4*)(lbl + 1024 + lc), l1b = *(const f32x4*)(lbl + 1024 + lc + 4);
#pragma unroll
            for (int e = 0; e < 8; ++e) { const float l0 = e < 4 ? l0a[e & 3] : l0b[e & 3], l1 = e < 4 ? l1a[e & 3] : l1b[e & 3];
                const float lb = 1.f / (1.f + __expf(l1 - l0)); const float f = lb + (1.f - lb) * sigmoidf_(a[e]); o[e] = logf(f); }
            *(f32x4*)(logfo + r1) = (f32x4){o[0], o[1], o[2], o[3]}; *(f32x4*)(logfo + r1 + 4) = (f32x4){o[4], o[5], o[6], o[7]};
        } else if (reg == 5) { st8bf(v + r1, a);
        } else if (reg == 6) {
#pragma unroll
            for (int e = 0; e < 8; ++e) o[e] = siluf_(a[e]);
            st8bf(sgate + r1, o);
        } else {
#pragma unroll
            for (int e = 0; e < 8; ++e) o[e] = sigmoidf_(a[e]);
            u32x2 pk; pk[0] = (unsigned)(o[0] * 255.f + 0.5f) | ((unsigned)(o[1] * 255.f + 0.5f) << 8) | ((unsigned)(o[2] * 255.f + 0.5f) << 16) | ((unsigned)(o[3] * 255.f + 0.5f) << 24);
            pk[1] = (unsigned)(o[4] * 255.f + 0.5f) | ((unsigned)(o[5] * 255.f + 0.5f) << 8) | ((unsigned)(o[6] * 255.f + 0.5f) << 16) | ((unsigned)(o[7] * 255.f + 0.5f) << 24);
            if (reg < 9) *(u32x2*)(sga + (size_t)row * 2048 + (c - 7168)) = pk; else *(u32x2*)(sgb + (size_t)row * 2048 + (c - 9216)) = pk;
        }
    }
    __device__ __forceinline__ void operator()(int row, int cA, const float* vA, int cB, const float* vB, const Unit&) const { one(row, cA, vA); one(row, cB, vB); }
};
struct FA {
    bf16_t* merged; const unsigned char* sg;
    __device__ __forceinline__ void one(int row, int c, const float* a) const {
        const size_t o = (size_t)row * 2048 + c; const u32x2 g = *(const u32x2*)(sg + o); float r[8];
#pragma unroll
        for (int e = 0; e < 8; ++e) r[e] = a[e] * ((float)((g[e >> 2] >> (8 * (e & 3))) & 255u) * (1.f / 255.f));
        st8bf(merged + o, r);
    }
    __device__ __forceinline__ void operator()(int row, int cA, const float* vA, int cB, const float* vB, const Unit&) const { one(row, cA, vA); one(row, cB, vB); }
};
struct FB {
    bf16_t* merged; const unsigned char* sg;
    __device__ __forceinline__ void one(int row, int c, const float* a) const {
        const size_t o = (size_t)row * 2048 + c; const u32x2 g = *(const u32x2*)(sg + o); const u32x4 mm = *(const u32x4*)(merged + o); float r[8];
#pragma unroll
        for (int e = 0; e < 8; ++e) r[e] = ((e & 1) ? bfhi(mm[e >> 1]) : bflo(mm[e >> 1])) + a[e] * ((float)((g[e >> 2] >> (8 * (e & 3))) & 255u) * (1.f / 255.f));
        st8bf(merged + o, r);
    }
    __device__ __forceinline__ void operator()(int row, int cA, const float* vA, int cB, const float* vB, const Unit&) const { one(row, cA, vA); one(row, cB, vB); }
};
struct FO {
    const float* x; const float* g2; float* x1; bf16_t* xg2; float* sumsq;
    __device__ __forceinline__ float one(int row, int c, const float* a) const {
        const size_t o = (size_t)row * 2048 + c; const f32x4 xa = *(const f32x4*)(x + o), xb = *(const f32x4*)(x + o + 4), ga = *(const f32x4*)(g2 + c), gb = *(const f32x4*)(g2 + c + 4);
        float r[8], s = 0.f, w[8];
#pragma unroll
        for (int e = 0; e < 8; ++e) { r[e] = a[e] + (e < 4 ? xa[e & 3] : xb[e & 3]); s += r[e] * r[e]; w[e] = r[e] * (e < 4 ? ga[e & 3] : gb[e & 3]); }
        *(f32x4*)(x1 + o) = (f32x4){r[0], r[1], r[2], r[3]}; *(f32x4*)(x1 + o + 4) = (f32x4){r[4], r[5], r[6], r[7]};
        st8bf(xg2 + o, w); return s;
    }
    __device__ __forceinline__ void operator()(int row, int cA, const float* vA, int cB, const float* vB, const Unit& u) const {
        float s = one(row, cA, vA) + one(row, cB, vB);
        s += __shfl_xor(s, 16); s += __shfl_xor(s, 32);
        if ((threadIdx.x & 63) < 16) sumsq[(size_t)row * 32 + u.pn * 4 + ((threadIdx.x >> 6) & 3)] = s;
    }
};
struct FQ {
    bf16_t* qp; const float* sumsq;
    __device__ __forceinline__ void operator()(int row, int cA, const float* vA, int cB, const float* vB, const Unit&) const {
        const float rs = row_rstd(sumsq, row); float r[8];
#pragma unroll
        for (int e = 0; e < 8; ++e) r[e] = vA[e] * rs;
        st8bf(qp + (size_t)row * 2048 + cA, r);
#pragma unroll
        for (int e = 0; e < 8; ++e) r[e] = vB[e] * rs;
        st8bf(qp + (size_t)row * 2048 + cB, r);
    }
};
template <class F> __device__ __forceinline__ void run_gemm(unsigned char* smem, const bf16_t* A, const bf16_t* Bt, int M, int N, int K, const F& f) {
    Gemm g; g.A = A; g.Bt = Bt; g.M = M; g.N = N; g.K = K;
    StaticOrder S; S.init(M, N, (int)gridDim.x, (int)blockIdx.x);
    EpiRow<F> E{f};
    gemm_phase<EpiRow<F>, StaticOrder>((LAS unsigned char*)smem, g, S, E);
    __syncthreads();
}
__device__ __forceinline__ void transpose_tile(const float* src, int ldsrc, int srccol0, bf16_t* dst, int K, int k0, int n0, float* tl) {
    const int tid = threadIdx.x, j4 = tid & 31, i = tid >> 5;
    f32x4 v[4];
#pragma unroll
    for (int r = 0; r < 4; ++r) v[r] = *(const f32x4*)(src + (size_t)(k0 + r * 16 + i) * ldsrc + srccol0 + j4 * 4);
#pragma unroll
    for (int r = 0; r < 4; ++r) { const int k = r * 16 + i;
#pragma unroll
        for (int e = 0; e < 4; ++e) tl[(j4 * 4 + e) * 65 + k] = v[r][e]; }
    __syncthreads();
    const int n = tid >> 2, kc = tid & 3; float o[16];
#pragma unroll
    for (int e = 0; e < 16; ++e) o[e] = tl[n * 65 + kc * 16 + e];
    st8bf(dst + (size_t)(n0 + n) * K + k0 + kc * 16, o); st8bf(dst + (size_t)(n0 + n) * K + k0 + kc * 16 + 8, o + 8);
    __syncthreads();
}
__device__ __forceinline__ void cvt_stream(const float* src, bf16_t* dst, size_t n) {
    const size_t nthr = (size_t)gridDim.x * 512, gt = (size_t)blockIdx.x * 512 + threadIdx.x;
    for (size_t i = gt * 8; i < n; i += nthr * 8) {
        const f32x4 a = *(const f32x4*)(src + i), b = *(const f32x4*)(src + i + 4);
        float v[8] = {a[0], a[1], a[2], a[3], b[0], b[1], b[2], b[3]};
        st8bf(dst + i, v);
    }
}
__device__ void phase_prep(const Params& p, unsigned char* smem) {
    const int tid = threadIdx.x, wid = tid >> 6, lane = tid & 63, nb = gridDim.x, b = blockIdx.x;
    unsigned char* ws = p.ws;
    float* tl = (float*)smem;
    float* wff = (float*)(smem + 36864);
    {
        for (int it = b; it < 32 * 88; it += nb) { const int kt = it / 88, nt = it % 88; const int n0 = nt * 128; transpose_tile(p.w_in, NIN_SRC, n0 < 3072 ? n0 : n0 + 8, (bf16_t*)(ws + OFF_WIN), 2048, kt * 64, n0, tl); }
        for (int it = b; it < 16 * 16; it += nb) { const int kt = it / 16, nt = it % 16; transpose_tile(p.w_a_up, 2048, nt * 128, (bf16_t*)(ws + OFF_WA), 1024, kt * 64, nt * 128, tl); }
        for (int it = b; it < 16 * 16; it += nb) { const int kt = it / 16, nt = it % 16; transpose_tile(p.w_b_up, 2048, nt * 128, (bf16_t*)(ws + OFF_WB), 1024, kt * 64, nt * 128, tl); }
        for (int it = b; it < 32 * 16; it += nb) { const int kt = it / 16, nt = it % 16; transpose_tile(p.w_o, 2048, nt * 128, (bf16_t*)(ws + OFF_WO), 2048, kt * 64, nt * 128, tl); }
        for (int it = b; it < 32 * 16; it += nb) { const int kt = it / 16, nt = it % 16; transpose_tile(p.peer_wq, 2048, nt * 128, (bf16_t*)(ws + OFF_WQ), 2048, kt * 64, nt * 128, tl); }
    }
    for (int i = tid; i < 2048 * 8; i += 512) { const int d = i >> 3, hh = i & 7; wff[hh * 2048 + d] = p.w_in[(size_t)d * NIN_SRC + 3072 + hh]; }
    __syncthreads();
    {
        bf16_t* h = (bf16_t*)p.out; float* logfa = (float*)(ws + OFF_LOGFA);
        const bool b5 = (lane & 32) != 0, b4 = (lane & 16) != 0, b3 = (lane & 8) != 0;
        f32x4 xn[8];
        { const int row = b * 8 + wid; if (row < T) {
#pragma unroll
            for (int i = 0; i < 8; ++i) xn[i] = *(const f32x4*)(p.x + (size_t)row * D + i * 256 + lane * 4); } }
#pragma unroll 1
        for (int row = b * 8 + wid; row < T; row += nb * 8) {
            f32x4 xv[8]; float ss = 0.f;
#pragma unroll
            for (int i = 0; i < 8; ++i) { xv[i] = xn[i]; ss += xv[i][0] * xv[i][0] + xv[i][1] * xv[i][1] + xv[i][2] * xv[i][2] + xv[i][3] * xv[i][3]; }
            { const int rown = row + nb * 8; if (rown < T) {
#pragma unroll
                for (int i = 0; i < 8; ++i) xn[i] = *(const f32x4*)(p.x + (size_t)rown * D + i * 256 + lane * 4); } }
            ss = wave_sum(ss); const float rs = rsqrtf(ss * (1.f / 2048.f) + EPS);
            float fa[8] = {0, 0, 0, 0, 0, 0, 0, 0};
#pragma unroll
            for (int i = 0; i < 8; ++i) {
                const f32x4 g = *(const f32x4*)(p.norm1_g + i * 256 + lane * 4);
                f32x4 hv; hv[0] = xv[i][0] * rs * g[0]; hv[1] = xv[i][1] * rs * g[1]; hv[2] = xv[i][2] * rs * g[2]; hv[3] = xv[i][3] * rs * g[3];
                u32x2 o; o[0] = cvt_pk_bf16_asm(hv[0], hv[1]); o[1] = cvt_pk_bf16_asm(hv[2], hv[3]);
                *(u32x2*)(h + (size_t)row * D + i * 256 + lane * 4) = o;
#pragma unroll
                for (int hh = 0; hh < 8; ++hh) { const f32x4 w = *(const f32x4*)(wff + hh * 2048 + i * 256 + lane * 4); fa[hh] += hv[0] * w[0] + hv[1] * w[1] + hv[2] * w[2] + hv[3] * w[3]; }
            }
            float r4[4], r2[2];
#pragma unroll
            for (int i = 0; i < 4; ++i) { const float mine = b5 ? fa[4 + i] : fa[i], oth = b5 ? fa[i] : fa[4 + i]; r4[i] = mine + __shfl_xor(oth, 32); }
#pragma unroll
            for (int i = 0; i < 2; ++i) { const float mine = b4 ? r4[2 + i] : r4[i], oth = b4 ? r4[i] : r4[2 + i]; r2[i] = mine + __shfl_xor(oth, 16); }
            float v1 = (b3 ? r2[1] : r2[0]) + __shfl_xor(b3 ? r2[0] : r2[1], 8); v1 += __shfl_xor(v1, 4); v1 += __shfl_xor(v1, 2); v1 += __shfl_xor(v1, 1);
            if ((lane & 7) == 0) { const int hh = lane >> 3; const float z = v1 + p.fox_f_bias[hh]; logfa[(size_t)row * 8 + hh] = fminf(z, 0.f) - log1pf(__expf(-fabsf(z))); }
        }
    }
    cvt_stream(p.peer_keys, (bf16_t*)(ws + OFF_KEYS), (size_t)8 * 2 * 128 * 128);
}
__device__ void hg_local_item(const Params& p, unsigned char* smem, int item) {
    const int tid = threadIdx.x, wid = tid >> 6, lane = tid & 63, r = lane & 15, q4 = lane >> 4;
    unsigned char* ws = p.ws;
    const int c = item >> 3, h = item & 7, t0 = c * 64;
    bf16_t* qeS = (bf16_t*)smem;
    bf16_t* keS = qeS + 64 * 136;
    bf16_t* kdT = keS + 64 * 136;
    bf16_t* vT = kdT + 128 * 72;
    bf16_t* Am = vT + 128 * 72;
    float* segsum = (float*)(Am + 64 * 72);
    const float* logf = (const float*)((const unsigned char*)p.out + OUT_LOGF); const bf16_t* qin = (const bf16_t*)(ws + OFF_QIN); const bf16_t* vin = (const bf16_t*)(ws + OFF_V);
    bf16_t* qeG = (bf16_t*)(ws + OFF_QE); float* dec = (float*)(ws + OFF_DEC); float* ointra = (float*)(ws + OFF_OINTRA); bf16_t* LT = (bf16_t*)(ws + OFF_LT);
    float* nmS = segsum + 512;
    {
        const bf16_t* fqp = (const bf16_t*)(ws + OFF_FQ); const bf16_t* fkp = (const bf16_t*)(ws + OFF_FK);
        const size_t o = (size_t)(t0 + (tid >> 3)) * 1024 + h * 128 + (tid & 7) * 16; float sa = 0.f, sb = 0.f;
#pragma unroll
        for (int u = 0; u < 2; ++u) { const u32x4 a = *(const u32x4*)(fqp + o + u * 8), bq = *(const u32x4*)(fkp + o + u * 8);
#pragma unroll
            for (int e = 0; e < 4; ++e) { sa += bflo(a[e]) * bflo(a[e]) + bfhi(a[e]) * bfhi(a[e]); sb += bflo(bq[e]) * bflo(bq[e]) + bfhi(bq[e]) * bfhi(bq[e]); } }
#pragma unroll
        for (int o2 = 1; o2 < 8; o2 <<= 1) { sa += __shfl_xor(sa, o2); sb += __shfl_xor(sb, o2); }
#pragma unroll
        for (int o2 = 8; o2 < 64; o2 <<= 1) { sa = fmaxf(sa, __shfl_xor(sa, o2)); sb = fmaxf(sb, __shfl_xor(sb, o2)); }
        if (lane == 0) { nmS[wid] = sa; nmS[8 + wid] = sb; }
    }
    {
        const int k = tid & 127, seg = tid >> 7;
        float lf[16], bl[16]; float run = 0.f; bf16_t qv[16], vv[16];
        const size_t base = (size_t)(t0 + seg * 16) * 1024 + h * 128 + k;
#pragma unroll
        for (int i = 0; i < 16; ++i) { lf[i] = logf[base + (size_t)i * 1024]; qv[i] = qin[base + (size_t)i * 1024]; vv[i] = vin[base + (size_t)i * 1024]; }
        __builtin_amdgcn_sched_barrier(0);
#pragma unroll
        for (int i = 0; i < 16; ++i) { run += lf[i]; bl[i] = run; }
        segsum[seg * 128 + k] = run;
        __syncthreads();
        float off = 0.f, tot = 0.f;
#pragma unroll
        for (int s = 0; s < 4; ++s) { const float v = segsum[s * 128 + k]; off += (s < seg) ? v : 0.f; tot += v; }
#pragma unroll
        for (int i = 0; i < 16; ++i) {
            const int t = seg * 16 + i; const float bb = bl[i] + off; const float kk = 1.f - __expf(lf[i]);
            const float q = bf2f(qv[i]);
            const bf16_t qe = f2bf(q * __expf(bb));
            qeS[t * 136 + k] = qe; qeG[base + (size_t)i * 1024] = qe;
            keS[t * 136 + k] = f2bf(kk * __expf(-bb));
            kdT[k * 72 + t] = f2bf(kk * __expf(tot - bb));
            vT[k * 72 + t] = vv[i];
        }
        if (seg == 0) dec[item * 128 + k] = __expf(tot);
        if (tid == 0) { float a = 0.f, b2 = 0.f;
#pragma unroll
            for (int w = 0; w < 8; ++w) { a = fmaxf(a, nmS[w]); b2 = fmaxf(b2, nmS[8 + w]); }
            float* nm = (float*)(ws + OFF_NM); nm[item * 2] = a; nm[item * 2 + 1] = b2; }
    }
    __syncthreads();
    {
        const int tt = wid >> 1;
#pragma unroll
        for (int u = 0; u < 2; ++u) {
            const int st = (wid & 1) * 2 + u;
            f32x4 acc = {0.f, 0.f, 0.f, 0.f};
            if (st <= tt) {
#pragma unroll
                for (int ks = 0; ks < 4; ++ks) acc = mfma16(*(const bf16x8*)(qeS + (tt * 16 + r) * 136 + ks * 32 + q4 * 8), *(const bf16x8*)(keS + (st * 16 + r) * 136 + ks * 32 + q4 * 8), acc);
            }
#pragma unroll
            for (int j = 0; j < 4; ++j) { const int t = tt * 16 + q4 * 4 + j, s = st * 16 + r; Am[t * 72 + s] = f2bf((s <= t) ? acc[j] : 0.f); }
        }
    }
    __syncthreads();
    {
        const int tt = wid & 3;
#pragma unroll
        for (int u = 0; u < 4; ++u) {
            const int vt = (wid >> 2) * 4 + u; f32x4 acc = {0.f, 0.f, 0.f, 0.f};
#pragma unroll
            for (int ks = 0; ks < 2; ++ks) acc = mfma16(*(const bf16x8*)(vT + (vt * 16 + r) * 72 + ks * 32 + q4 * 8), *(const bf16x8*)(Am + (tt * 16 + r) * 72 + ks * 32 + q4 * 8), acc);
            *(f32x4*)(ointra + (size_t)(t0 + tt * 16 + r) * 1024 + h * 128 + vt * 16 + q4 * 4) = acc;
        }
    }
    {
        const int vt = wid;
#pragma unroll
        for (int kt = 0; kt < 8; ++kt) {
            f32x4 acc = {0.f, 0.f, 0.f, 0.f};
#pragma unroll
            for (int ks = 0; ks < 2; ++ks) acc = mfma16(*(const bf16x8*)(kdT + (kt * 16 + r) * 72 + ks * 32 + q4 * 8), *(const bf16x8*)(vT + (vt * 16 + r) * 72 + ks * 32 + q4 * 8), acc);
            u32x2 o; o[0] = cvt_pk_bf16(acc[0], acc[1]); o[1] = cvt_pk_bf16(acc[2], acc[3]);
            *(u32x2*)(LT + (size_t)item * 16384 + (vt * 16 + r) * 128 + kt * 16 + q4 * 4) = o;
        }
    }
    __syncthreads();
}
__device__ void fox_scan_item(const Params& p, unsigned char* smem, int h) {
    const int tid = threadIdx.x, wid = tid >> 6, lane = tid & 63;
    unsigned char* ws = p.ws;
    const float* logfa = (const float*)(ws + OFF_LOGFA); float* cf = (float*)(ws + OFF_CFOX) + (size_t)h * T;
    float* wtot = (float*)smem;
    float loc[16]; float run = 0.f;
#pragma unroll
    for (int i = 0; i < 16; ++i) { run += logfa[(size_t)(tid * 16 + i) * 8 + h]; loc[i] = run; }
    float inc = run;
#pragma unroll
    for (int o = 1; o < 64; o <<= 1) { const float n = __shfl_up(inc, o); if (lane >= o) inc += n; }
    if (lane == 63) wtot[wid] = inc;
    __syncthreads();
    float off = 0.f;
#pragma unroll
    for (int w = 0; w < 8; ++w) off += (w < wid) ? wtot[w] : 0.f;
    off += inc - run;
#pragma unroll
    for (int i = 0; i < 16; ++i) cf[tid * 16 + i] = off + loc[i];
    __syncthreads();
}
__device__ void phase_hg_local(const Params& p, unsigned char* smem) {
    for (int it = blockIdx.x; it < 8 + 1024; it += gridDim.x) { if (it < 8) fox_scan_item(p, smem, it); else hg_local_item(p, smem, it - 8); }
}
__device__ void attn_item(const Params& p, unsigned char* smem, int item) {
    const int tid = threadIdx.x, wid = tid >> 6, lane = tid & 63, r = lane & 15, q4 = lane >> 4;
    unsigned char* ws = p.ws;
    const int h = item & 7, qb = item >> 3, t0 = qb * 128, tw = t0 + wid * 16;
    bf16_t* Ks = (bf16_t*)smem;
    bf16_t* vT = Ks + 64 * 136;
    float* csS = (float*)(vT + 128 * 72);
    const bf16_t* fq = (const bf16_t*)(ws + OFF_FQ); const bf16_t* fk = (const bf16_t*)(ws + OFF_FK); const bf16_t* fv = (const bf16_t*)(ws + OFF_FV);
    const float* cf = (const float*)(ws + OFF_CFOX) + (size_t)h * T; bf16_t* ya = (bf16_t*)(ws + OFF_YA);
    bf16x8 qf[4];
#pragma unroll
    for (int ks = 0; ks < 4; ++ks) qf[ks] = *(const bf16x8*)(fq + (size_t)(tw + r) * 1024 + h * 128 + ks * 32 + q4 * 8);
    const int trow = tw + r; const float ct = cf[trow];
    float bqk;
    {
        float a = 0.f, b2 = 0.f;
        if (tid < 128) { const float* nm = (const float*)(ws + OFF_NM) + (size_t)(tid * 8 + h) * 2; a = nm[0]; b2 = nm[1]; }
#pragma unroll
        for (int o2 = 1; o2 < 64; o2 <<= 1) { a = fmaxf(a, __shfl_xor(a, o2)); b2 = fmaxf(b2, __shfl_xor(b2, o2)); }
        __syncthreads();
        if (lane == 0 && wid < 2) { csS[wid] = a; csS[2 + wid] = b2; }
        __syncthreads();
        bqk = sqrtf(fmaxf(csS[0], csS[1])) * sqrtf(fmaxf(csS[2], csS[3])) * 1.01f;
    }
    const float thr = -(26.f + 2.f * bqk);
    const float c0 = cf[t0];
    int lo = 0, hi = 2 * qb;
    while (lo < hi) { const int mid = (lo + hi) >> 1; if (c0 - cf[mid * 64 + 63] >= thr) hi = mid; else lo = mid + 1; }
    int j_lo = lo; const int j_hi = 2 * qb + 1;
    float m = -1e30f, l = 0.f;
    f32x4 O[8];
#pragma unroll
    for (int d = 0; d < 8; ++d) O[d] = (f32x4){0.f, 0.f, 0.f, 0.f};
    u32x4 kreg[2], vreg[2]; float creg = 0.f;
#define ATT_LOAD(J) do { _Pragma("unroll") for (int u = 0; u < 2; ++u) { const int ci = tid + u * 512, key = ci >> 4, dc = ci & 15; const size_t go = (size_t)((J) * 64 + key) * 1024 + h * 128 + dc * 8; \
            kreg[u] = *(const u32x4*)(fk + go); vreg[u] = *(const u32x4*)(fv + go); } if (tid < 64) creg = cf[(J) * 64 + tid]; } while (0)
    ATT_LOAD(j_hi);
    for (int j = j_hi; j >= j_lo; --j) {
        __syncthreads();
#pragma unroll
        for (int u = 0; u < 2; ++u) {
            const int ci = tid + u * 512, key = ci >> 4, dc = ci & 15;
            *(u32x4*)(Ks + key * 136 + dc * 8) = kreg[u];
            const u32x4 vv = vreg[u];
            const int kpos = (((key >> 2) ^ dc) << 2) + (key & 3);
#pragma unroll
            for (int e = 0; e < 4; ++e) { vT[(dc * 8 + 2 * e) * 72 + kpos] = (bf16_t)(vv[e] & 0xffffu); vT[(dc * 8 + 2 * e + 1) * 72 + kpos] = (bf16_t)(vv[e] >> 16); }
        }
        if (tid < 64) csS[tid] = creg;
        __syncthreads();
        if (j > j_lo) ATT_LOAD(j - 1);
        if (j * 64 > tw + 15) continue;
        f32x4 S[4];
#pragma unroll
        for (int nt = 0; nt < 4; ++nt) { S[nt] = (f32x4){0.f, 0.f, 0.f, 0.f};
#pragma unroll
            for (int ks = 0; ks < 4; ++ks) S[nt] = mfma16(*(const bf16x8*)(Ks + (nt * 16 + r) * 136 + ks * 32 + q4 * 8), qf[ks], S[nt]); }
        float mx = -INFINITY;
#pragma unroll
        for (int nt = 0; nt < 4; ++nt)
#pragma unroll
            for (int jj = 0; jj < 4; ++jj) { const int key = nt * 16 + q4 * 4 + jj; float v = S[nt][jj] + ct - csS[key]; v = (j * 64 + key <= trow) ? v : -INFINITY; S[nt][jj] = v; mx = fmaxf(mx, v); }
        mx = fmaxf(mx, __shfl_xor(mx, 16)); mx = fmaxf(mx, __shfl_xor(mx, 32));
        const float mn = fmaxf(m, mx), alpha = __expf(m - mn); m = mn;
        float rs = 0.f;
#pragma unroll
        for (int nt = 0; nt < 4; ++nt)
#pragma unroll
            for (int jj = 0; jj < 4; ++jj) { const float pe = __expf(S[nt][jj] - mn); S[nt][jj] = pe; rs += pe; }
        rs += __shfl_xor(rs, 16); rs += __shfl_xor(rs, 32);
        l = l * alpha + rs;
#pragma unroll
        for (int d = 0; d < 8; ++d) { O[d][0] *= alpha; O[d][1] *= alpha; O[d][2] *= alpha; O[d][3] *= alpha; }
#pragma unroll
        for (int k2 = 0; k2 < 2; ++k2) {
            u32x4 pp; pp[0] = cvt_pk_bf16(S[2 * k2][0], S[2 * k2][1]); pp[1] = cvt_pk_bf16(S[2 * k2][2], S[2 * k2][3]); pp[2] = cvt_pk_bf16(S[2 * k2 + 1][0], S[2 * k2 + 1][1]); pp[3] = cvt_pk_bf16(S[2 * k2 + 1][2], S[2 * k2 + 1][3]);
            const bf16x8 pf = __builtin_bit_cast(bf16x8, pp);
#pragma unroll
            for (int d = 0; d < 8; ++d) {
                const int sw = (d * 2 + (r >> 3)) & 15;
                const u32x2 va = *(const u32x2*)(vT + (d * 16 + r) * 72 + ((((2 * k2) * 4 + q4) ^ sw) << 2)), vb = *(const u32x2*)(vT + (d * 16 + r) * 72 + ((((2 * k2 + 1) * 4 + q4) ^ sw) << 2));
                u32x4 vv; vv[0] = va[0]; vv[1] = va[1]; vv[2] = vb[0]; vv[3] = vb[1];
                O[d] = mfma16(__builtin_bit_cast(bf16x8, vv), pf, O[d]);
            }
        }
        if (j == j_hi - 1 && j > j_lo) {
            float mm = m;
#pragma unroll
            for (int o2 = 1; o2 < 16; o2 <<= 1) mm = fminf(mm, __shfl_xor(mm, o2));
            if (lane == 0) csS[64 + wid] = mm;
            __syncthreads();
            float mmin = csS[64];
#pragma unroll
            for (int w = 1; w < 8; ++w) mmin = fminf(mmin, csS[64 + w]);
            const float thr2 = -(26.f + fmaxf(bqk - mmin, 0.f));
            int lo2 = j_lo, hi2 = j;
            while (lo2 < hi2) { const int mid = (lo2 + hi2) >> 1; if (c0 - cf[mid * 64 + 63] >= thr2) hi2 = mid; else lo2 = mid + 1; }
            j_lo = lo2;
        }
    }
#undef ATT_LOAD
    const float il = 1.f / l;
#pragma unroll
    for (int d = 0; d < 8; ++d) { u32x2 o; o[0] = cvt_pk_bf16(O[d][0] * il, O[d][1] * il); o[1] = cvt_pk_bf16(O[d][2] * il, O[d][3] * il);
        *(u32x2*)(ya + (size_t)trow * 1024 + h * 128 + d * 16 + q4 * 4) = o; }
    __syncthreads();
}
__device__ void hg_scan_item(const Params& p, int item) {
    const int tid = threadIdx.x; unsigned char* ws = p.ws;
    const int h = item & 7, vg = item >> 3; const int v = vg * 4 + (tid >> 7), k = tid & 127;
    const bf16_t* LT = (const bf16_t*)(ws + OFF_LT); const float* dec = (const float*)(ws + OFF_DEC); bf16_t* ST = (bf16_t*)(ws + OFF_ST);
    float s = 0.f;
#pragma unroll 1
    for (int c0 = 0; c0 < 128; c0 += 16) {
        bf16_t lt[16]; float dd[16];
#pragma unroll
        for (int u = 0; u < 16; ++u) { const int it = (c0 + u) * 8 + h; lt[u] = LT[(size_t)it * 16384 + v * 128 + k]; dd[u] = dec[it * 128 + k]; }
        __builtin_amdgcn_sched_barrier(0);
#pragma unroll
        for (int u = 0; u < 16; ++u) { const int it = (c0 + u) * 8 + h; ST[(size_t)it * 16384 + v * 128 + k] = f2bf(s); s = dd[u] * s + bf2f(lt[u]); }
    }
}
__device__ void phase_attn_scan(const Params& p, unsigned char* smem) {
    for (int it = blockIdx.x; it < 256 + 512; it += gridDim.x) { if (it < 256) hg_scan_item(p, it); else attn_item(p, smem, it - 256); }
}
__device__ void phase_hg_out(const Params& p) {
    const int tid = threadIdx.x, wid = tid >> 6, lane = tid & 63, r = lane & 15, q4 = lane >> 4;
    unsigned char* ws = p.ws;
    const bf16_t* qe = (const bf16_t*)(ws + OFF_QE); const bf16_t* ST = (const bf16_t*)(ws + OFF_ST); const float* ointra = (const float*)(ws + OFF_OINTRA);
    const bf16_t* sgate = (const bf16_t*)(ws + OFF_SGATE); bf16_t* ob = (bf16_t*)(ws + OFF_OB);
    for (int wt = blockIdx.x * 8 + wid; wt < 4096; wt += gridDim.x * 8) {
        const int item = wt >> 2, tt = wt & 3, c = item >> 3, h = item & 7; const int t = c * 64 + tt * 16 + r;
        bf16x8 qf[4];
#pragma unroll
        for (int ks = 0; ks < 4; ++ks) qf[ks] = *(const bf16x8*)(qe + (size_t)t * 1024 + h * 128 + ks * 32 + q4 * 8);
        f32x4 o[8]; float ss = 0.f;
        bf16x8 sf[8][4];
#pragma unroll
        for (int vt = 0; vt < 8; ++vt) {
            o[vt] = *(const f32x4*)(ointra + (size_t)t * 1024 + h * 128 + vt * 16 + q4 * 4);
#pragma unroll
            for (int ks = 0; ks < 4; ++ks) sf[vt][ks] = *(const bf16x8*)(ST + (size_t)item * 16384 + (vt * 16 + r) * 128 + ks * 32 + q4 * 8);
        }
        __builtin_amdgcn_sched_barrier(0);
#pragma unroll
        for (int vt = 0; vt < 8; ++vt) {
            f32x4 acc = o[vt];
#pragma unroll
            for (int ks = 0; ks < 4; ++ks) acc = mfma16(sf[vt][ks], qf[ks], acc);
            o[vt] = acc; ss += acc[0] * acc[0] + acc[1] * acc[1] + acc[2] * acc[2] + acc[3] * acc[3];
        }
        ss += __shfl_xor(ss, 16); ss += __shfl_xor(ss, 32);
        const float rs = rsqrtf(ss * (1.f / 128.f) + EPS);
#pragma unroll
        for (int vt = 0; vt < 8; ++vt) {
            const int col = h * 128 + vt * 16 + q4 * 4; const f32x4 g = *(const f32x4*)(p.hg_norm_g + col); const u32x2 sg = *(const u32x2*)(sgate + (size_t)t * 1024 + col);
            u32x2 w; w[0] = cvt_pk_bf16(o[vt][0] * rs * g[0] * bflo(sg[0]), o[vt][1] * rs * g[1] * bfhi(sg[0])); w[1] = cvt_pk_bf16(o[vt][2] * rs * g[2] * bflo(sg[1]), o[vt][3] * rs * g[3] * bfhi(sg[1]));
            *(u32x2*)(ob + (size_t)t * 1024 + col) = w;
        }
    }
}
__device__ void phase_route(const Params& p, unsigned char* smem) {
    const int tid = threadIdx.x, wid = tid >> 6, lane = tid & 63, r = lane & 15, q4 = lane >> 4;
    unsigned char* ws = p.ws;
    const bf16_t* qp = (const bf16_t*)(ws + OFF_QP); const bf16_t* keys = (const bf16_t*)(ws + OFF_KEYS);
    int* idxo = (int*)(ws + OFF_IDX); float* gateo = (float*)(ws + OFF_GATE);
    float* sc = (float*)smem;
    float* top = sc + 128 * 129;
    float* part = top + 128 * 17;
    for (int item = blockIdx.x; item < 128 * 8; item += gridDim.x) {
        const int h = item & 7, t0 = (item >> 3) * 64;
        {
            const int c = wid >> 2, tt = wid & 3;
            bf16x8 af[4];
#pragma unroll
            for (int ks = 0; ks < 4; ++ks) af[ks] = *(const bf16x8*)(qp + (size_t)(t0 + tt * 16 + r) * 2048 + h * 256 + c * 128 + ks * 32 + q4 * 8);
            const bf16_t* kb = keys + (size_t)((h * 2 + c) * 128 + r) * 128 + q4 * 8;
#pragma unroll
            for (int half = 0; half < 2; ++half) {
                bf16x8 kf[4][4];
#pragma unroll
                for (int n2 = 0; n2 < 4; ++n2)
#pragma unroll
                    for (int ks = 0; ks < 4; ++ks) kf[n2][ks] = *(const bf16x8*)(kb + (size_t)((half * 4 + n2) * 16) * 128 + ks * 32);
                __builtin_amdgcn_sched_barrier(0);
#pragma unroll
                for (int n2 = 0; n2 < 4; ++n2) {
                    const int nt = half * 4 + n2; f32x4 acc = {0.f, 0.f, 0.f, 0.f};
#pragma unroll
                    for (int ks = 0; ks < 4; ++ks) acc = mfma16(af[ks], kf[n2][ks], acc);
#pragma unroll
                    for (int jj = 0; jj < 4; ++jj) sc[(c * 64 + tt * 16 + q4 * 4 + jj) * 129 + nt * 16 + r] = acc[jj];
                }
                __builtin_amdgcn_sched_barrier(0);
            }
        }
        __syncthreads();
        {
            const int row = tid & 127, qq = tid >> 7;
            float lst[16];
#pragma unroll
            for (int i = 0; i < 16; ++i) lst[i] = -INFINITY;
            const float* rowp = sc + row * 129 + qq * 32;
#pragma unroll 4
            for (int n = 0; n < 32; ++n) {
                float x = __uint_as_float((__float_as_uint(rowp[n]) & ~127u) | (unsigned)(qq * 32 + n));
#pragma unroll
                for (int i = 0; i < 16; ++i) { const float hi = fmaxf(lst[i], x); x = fminf(lst[i], x); lst[i] = hi; }
            }
#pragma unroll
            for (int i = 0; i < 16; ++i) part[row * 65 + qq * 16 + i] = lst[i];
        }
        __syncthreads();
        if (tid < 128) {
            const float* L = part + tid * 65; int p0 = 0, p1 = 0, p2 = 0, p3 = 0; float h0 = L[0], h1 = L[16], h2 = L[32], h3 = L[48];
#pragma unroll 1
            for (int k = 0; k < 16; ++k) {
                const float m = fmaxf(fmaxf(h0, h1), fmaxf(h2, h3)); top[tid * 17 + k] = m;
                if (m == h0) { ++p0; h0 = p0 < 16 ? L[p0] : -INFINITY; } else if (m == h1) { ++p1; h1 = p1 < 16 ? L[16 + p1] : -INFINITY; }
                else if (m == h2) { ++p2; h2 = p2 < 16 ? L[32 + p2] : -INFINITY; } else { ++p3; h3 = p3 < 16 ? L[48 + p3] : -INFINITY; }
            }
        }
        __syncthreads();
        if (tid < 64) {
            float a[16], bb[16], best[16];
#pragma unroll
            for (int i = 0; i < 16; ++i) { a[i] = top[tid * 17 + i]; bb[i] = top[(64 + tid) * 17 + i]; best[i] = -INFINITY; }
#pragma unroll
            for (int i = 0; i < 16; ++i)
#pragma unroll
                for (int j = 0; j < 16; ++j) if ((i + 1) * (j + 1) <= 16) {
                    float x = __uint_as_float((__float_as_uint(a[i] + bb[j]) & ~255u) | (unsigned)(i * 16 + j));
#pragma unroll
                    for (int k = 0; k < 16; ++k) { const float hi = fmaxf(best[k], x); x = fminf(best[k], x); best[k] = hi; }
                }
            float e[16], sum = 0.f;
#pragma unroll
            for (int k = 0; k < 16; ++k) { e[k] = __expf(best[k] - best[0]); sum += e[k]; }
            const float inv = 1.f / sum; const size_t ob = (size_t)(t0 + tid) * 128 + h * 16;
#pragma unroll
            for (int k = 0; k < 16; ++k) {
                const unsigned pos = __float_as_uint(best[k]) & 255u; const int i = pos >> 4, j = pos & 15;
                const int i0 = (int)(__float_as_uint(top[tid * 17 + i]) & 127u), i1 = (int)(__float_as_uint(top[(64 + tid) * 17 + j]) & 127u);
                idxo[ob + k] = i0 * 128 + i1; gateo[ob + k] = e[k] * inv;
            }
        }
        __syncthreads();
    }
}
__device__ void cvt_rows_fp8(const float* src, unsigned char* dst, float* scl, int wave, int nw) {
    const int lane = threadIdx.x & 63;
#pragma unroll 1
    for (int row0 = wave; row0 < 16384; row0 += nw * 2) {
        f32x4 v[2][8];
#pragma unroll
        for (int rr = 0; rr < 2; ++rr) { const int row = row0 + rr * nw; if (row < 16384) {
#pragma unroll
            for (int k = 0; k < 8; ++k) v[rr][k] = *(const f32x4*)(src + (size_t)row * 2048 + k * 256 + lane * 4); } }
#pragma unroll
        for (int rr = 0; rr < 2; ++rr) { const int row = row0 + rr * nw; if (row < 16384) {
            float mx = 0.f;
#pragma unroll
            for (int k = 0; k < 8; ++k) mx = fmaxf(mx, fmaxf(fmaxf(fabsf(v[rr][k][0]), fabsf(v[rr][k][1])), fmaxf(fabsf(v[rr][k][2]), fabsf(v[rr][k][3]))));
#pragma unroll
            for (int o = 32; o > 0; o >>= 1) mx = fmaxf(mx, __shfl_xor(mx, o));
            const float q = mx > 0.f ? 416.f / mx : 0.f;
#pragma unroll
            for (int k = 0; k < 8; ++k) { int w = 0; w = __builtin_amdgcn_cvt_pk_fp8_f32(v[rr][k][0] * q, v[rr][k][1] * q, w, false); w = __builtin_amdgcn_cvt_pk_fp8_f32(v[rr][k][2] * q, v[rr][k][3] * q, w, true);
                *(int*)(dst + (size_t)row * 2048 + k * 256 + lane * 4) = w; }
            if (lane == 0) scl[row] = mx * (1.f / 416.f);
        } }
    }
}
__device__ __forceinline__ float gelu_tanh(float x) { const float u = 0.7978845608028654f * (x + 0.044715f * x * x * x); const float t = 1.f - 2.f / (1.f + __expf(2.f * u)); return 0.5f * x * (1.f + t); }
__device__ void phase_peer(const Params& p) {
    const int tid = threadIdx.x, wid = tid >> 6, lane = tid & 63;
    unsigned char* ws = p.ws;
    const bf16_t* xg2 = (const bf16_t*)(ws + OFF_XG2); const float* sumsq = (const float*)(ws + OFF_SUMSQ);
    const int* idx = (const int*)(ws + OFF_IDX); const float* gate = (const float*)(ws + OFF_GATE);
    const unsigned char* U8 = ws + OFF_U8; const unsigned char* V8 = ws + OFF_V8; const float* usc = (const float*)(ws + OFF_USC); const float* vsc = (const float*)(ws + OFF_VSC);
    for (int t = blockIdx.x * 8 + wid; t < T; t += gridDim.x * 8) {
        const int tu = __builtin_amdgcn_readfirstlane(t);
        const float rs = row_rstd(sumsq, tu);
        float xv[32];
#pragma unroll
        for (int i = 0; i < 2; ++i)
#pragma unroll
            for (int hq = 0; hq < 2; ++hq) { const u32x4 a = *(const u32x4*)(xg2 + (size_t)tu * 2048 + i * 1024 + lane * 16 + hq * 8);
#pragma unroll
                for (int e = 0; e < 4; ++e) { xv[i * 16 + hq * 8 + 2 * e] = bflo(a[e]) * rs; xv[i * 16 + hq * 8 + 2 * e + 1] = bfhi(a[e]) * rs; } }
        const int e0 = idx[(size_t)tu * 128 + lane], e1 = idx[(size_t)tu * 128 + 64 + lane];
        const float us0 = usc[e0], us1 = usc[e1], vs0 = vsc[e0], vs1 = vsc[e1], g0 = gate[(size_t)tu * 128 + lane], g1 = gate[(size_t)tu * 128 + 64 + lane];
        float w0 = 0.f, w1 = 0.f;
        const bool b5 = (lane & 32) != 0, b4 = (lane & 16) != 0;
#define P10_ISSUE(BUF, TAB, B) do { _Pragma("unroll") for (int u = 0; u < 4; ++u) { const int e = __builtin_amdgcn_readlane((B) < 16 ? e0 : e1, (((B) & 15) << 2) + u); \
            const unsigned char* rp = (TAB) + (size_t)e * 2048 + lane * 16; BUF[u][0] = *(const u32x4*)rp; BUF[u][1] = *(const u32x4*)(rp + 1024); } } while (0)
#define P10_UDOT(BUF, B) do { float d[4]; _Pragma("unroll") for (int u = 0; u < 4; ++u) { float sacc = 0.f; _Pragma("unroll") for (int i = 0; i < 2; ++i) _Pragma("unroll") for (int q = 0; q < 4; ++q) { \
                const f32x2_t lo = __builtin_amdgcn_cvt_pk_f32_fp8((int)BUF[u][i][q], false), hi = __builtin_amdgcn_cvt_pk_f32_fp8((int)BUF[u][i][q], true); \
                sacc += lo[0] * xv[i * 16 + 4 * q] + lo[1] * xv[i * 16 + 4 * q + 1] + hi[0] * xv[i * 16 + 4 * q + 2] + hi[1] * xv[i * 16 + 4 * q + 3]; } d[u] = sacc; } \
            float r2[2]; _Pragma("unroll") for (int i = 0; i < 2; ++i) { const float mine = b5 ? d[2 + i] : d[i], oth = b5 ? d[i] : d[2 + i]; r2[i] = mine + __shfl_xor(oth, 32); } \
            float v1 = (b4 ? r2[1] : r2[0]) + __shfl_xor(b4 ? r2[0] : r2[1], 16); v1 += __shfl_xor(v1, 8); v1 += __shfl_xor(v1, 4); v1 += __shfl_xor(v1, 2); v1 += __shfl_xor(v1, 1); \
            const float mineT = __shfl(v1, (lane & 3) << 4);        \
            if ((lane >> 2) == ((B) & 15)) { if ((B) < 16) w0 = mineT; else w1 = mineT; } } while (0)
#define P10_VACC(BUF, B) do { _Pragma("unroll") for (int u = 0; u < 4; ++u) { const float w = __uint_as_float((unsigned)__builtin_amdgcn_readlane((int)__float_as_uint((B) < 16 ? w0 : w1), (((B) & 15) << 2) + u)); \
            _Pragma("unroll") for (int i = 0; i < 2; ++i) _Pragma("unroll") for (int q = 0; q < 4; ++q) { \
                const f32x2_t lo = __builtin_amdgcn_cvt_pk_f32_fp8((int)BUF[u][i][q], false), hi = __builtin_amdgcn_cvt_pk_f32_fp8((int)BUF[u][i][q], true); \
                acc[i * 16 + 4 * q] += w * lo[0]; acc[i * 16 + 4 * q + 1] += w * lo[1]; acc[i * 16 + 4 * q + 2] += w * hi[0]; acc[i * 16 + 4 * q + 3] += w * hi[1]; } } } while (0)
        u32x4 bufA[4][2], bufB[4][2];
        P10_ISSUE(bufA, U8, 0);
#pragma unroll 1
        for (int b2 = 0; b2 < 32; b2 += 2) {
            P10_ISSUE(bufB, U8, b2 + 1);
            P10_UDOT(bufA, b2);
            if (b2 + 2 < 32) P10_ISSUE(bufA, U8, b2 + 2); else P10_ISSUE(bufA, V8, 0);
            P10_UDOT(bufB, b2 + 1);
        }
        w0 = gelu_tanh(w0 * us0) * g0 * vs0; w1 = gelu_tanh(w1 * us1) * g1 * vs1;
        float acc[32];
#pragma unroll
        for (int i = 0; i < 32; ++i) acc[i] = 0.f;
#pragma unroll 1
        for (int b2 = 0; b2 < 32; b2 += 2) {
            P10_ISSUE(bufB, V8, b2 + 1);
            P10_VACC(bufA, b2);
            if (b2 + 2 < 32) P10_ISSUE(bufA, V8, b2 + 2);
            P10_VACC(bufB, b2 + 1);
        }
#undef P10_ISSUE
#undef P10_UDOT
#undef P10_VACC
        float* orow = p.out + (size_t)tu * 2048; float ss = 0.f;
#pragma unroll
        for (int i = 0; i < 2; ++i)
#pragma unroll
            for (int c = 0; c < 4; ++c) { const f32x4 a = *(const f32x4*)(orow + i * 1024 + lane * 16 + c * 4);
#pragma unroll
                for (int e = 0; e < 4; ++e) { acc[i * 16 + c * 4 + e] += a[e]; ss += acc[i * 16 + c * 4 + e] * acc[i * 16 + c * 4 + e]; } }
        ss = wave_sum(ss); const float rf = rsqrtf(ss * (1.f / 2048.f) + EPS);
#pragma unroll
        for (int i = 0; i < 2; ++i)
#pragma unroll
            for (int c = 0; c < 4; ++c) { const f32x4 g = *(const f32x4*)(p.norm_f_g + i * 1024 + lane * 16 + c * 4); f32x4 o;
#pragma unroll
                for (int e = 0; e < 4; ++e) o[e] = acc[i * 16 + c * 4 + e] * rf * g[e];
                *(f32x4*)(orow + i * 1024 + lane * 16 + c * 4) = o; }
    }
}

#ifndef DBG_STOP
#define DBG_STOP 0
#endif
__device__ void dbg_dump(const Params& p, const void* A, int a_f32, const void* B, int b_f32) {
    for (size_t i = (size_t)blockIdx.x * 512 + threadIdx.x; i < (size_t)T * 2048; i += (size_t)gridDim.x * 512) {
        const size_t t = i >> 11; const int c = (int)(i & 2047); const void* S = c < 1024 ? A : B; const int f = c < 1024 ? a_f32 : b_f32; const size_t o = t * 1024 + (c & 1023);
        p.out[i] = f ? ((const float*)S)[o] : bf2f(((const bf16_t*)S)[o]);
    }
}
__device__ __forceinline__ void fast_barrier(unsigned* bar, unsigned k) {
    asm volatile("s_waitcnt vmcnt(0)" ::: "memory");
    __syncthreads();
    if (threadIdx.x == 0) {
        __builtin_amdgcn_fence(__ATOMIC_RELEASE, "agent");
        asm volatile("s_waitcnt vmcnt(0)" ::: "memory");
        const unsigned g = blockIdx.x & 7u, ngr = gridDim.x < 8u ? gridDim.x : 8u, gsz = (gridDim.x - g + 7u) >> 3;
        const unsigned v = __hip_atomic_fetch_add(bar + 64u * g, 1u, __ATOMIC_RELAXED, __HIP_MEMORY_SCOPE_AGENT);
        if (v + 1u == gsz * k) {
            const unsigned t = __hip_atomic_fetch_add(bar + 64u * 8u, 1u, __ATOMIC_RELAXED, __HIP_MEMORY_SCOPE_AGENT);
            if (t + 1u == ngr * k) { for (unsigned j = 0; j < ngr; ++j) __hip_atomic_store(bar + 64u * (16u + j), k, __ATOMIC_RELAXED, __HIP_MEMORY_SCOPE_AGENT); }
        }
        while (__hip_atomic_load(bar + 64u * (16u + g), __ATOMIC_RELAXED, __HIP_MEMORY_SCOPE_AGENT) < k) __builtin_amdgcn_s_sleep(2);
        __builtin_amdgcn_fence(__ATOMIC_ACQUIRE, "agent");
        asm volatile("s_waitcnt vmcnt(0)" ::: "memory");
    }
    __syncthreads();
}
__global__ void __launch_bounds__(512, 2) fwd_megakernel(Params p) {
    extern __shared__ __attribute__((aligned(16))) unsigned char smem[];
    cg::grid_group grid = cg::this_grid();
#define GSYNC() do { asm volatile("s_waitcnt vmcnt(0)" ::: "memory"); grid.sync(); \
        if (threadIdx.x < 64) { __builtin_amdgcn_fence(__ATOMIC_ACQUIRE, "agent"); asm volatile("s_waitcnt vmcnt(0)" ::: "memory"); } __syncthreads(); } while (0)
    unsigned char* ws = p.ws;
    phase_prep(p, smem);
    if (p.ws == nullptr) GSYNC();
    fast_barrier((unsigned*)(ws + OFF_BAR), 1u);
    {
        FZ f; f.fq = (bf16_t*)(ws + OFF_FQ); f.fk = (bf16_t*)(ws + OFF_FK); f.fv = (bf16_t*)(ws + OFF_FV); f.qin = (bf16_t*)(ws + OFF_QIN); f.v = (bf16_t*)(ws + OFF_V);
        f.sgate = (bf16_t*)(ws + OFF_SGATE); f.sga = ws + OFF_SGA; f.sgb = ws + OFF_SGB; f.logfo = (float*)((unsigned char*)p.out + OUT_LOGF); f.lbl = p.hg_lb_logits;
        run_gemm(smem, (const bf16_t*)p.out, (const bf16_t*)(ws + OFF_WIN), T, NZ, 2048, f);
    }
    {
        const int nunits = (T / 256) * (NZ / 256), rem = nunits % (int)gridDim.x;
        const int first = rem ? rem : 0, nidle = (int)gridDim.x - first;
        if ((int)blockIdx.x >= first) { const int wv = ((int)blockIdx.x - first) * 8 + (int)(threadIdx.x >> 6);
            cvt_rows_fp8(p.peer_u, ws + OFF_U8, (float*)(ws + OFF_USC), wv, nidle * 8); cvt_rows_fp8(p.peer_v, ws + OFF_V8, (float*)(ws + OFF_VSC), wv, nidle * 8); }
    }
    fast_barrier((unsigned*)(ws + OFF_BAR), 2u);
    phase_hg_local(p, smem);
    fast_barrier((unsigned*)(ws + OFF_BAR), 3u);
    phase_attn_scan(p, smem);
    fast_barrier((unsigned*)(ws + OFF_BAR), 4u);
    if (DBG_STOP == 3) { dbg_dump(p, ws + OFF_YA, 0, ws + OFF_ST, 0); return; }
    phase_hg_out(p);
    fast_barrier((unsigned*)(ws + OFF_BAR), 5u);
    if (DBG_STOP == 4) { dbg_dump(p, ws + OFF_YA, 0, ws + OFF_OB, 0); return; }
    {
        FA fa; fa.merged = (bf16_t*)(ws + OFF_MERGED); fa.sg = ws + OFF_SGA;
        run_gemm(smem, (const bf16_t*)(ws + OFF_YA), (const bf16_t*)(ws + OFF_WA), T, 2048, 1024, fa);
        FB fb; fb.merged = (bf16_t*)(ws + OFF_MERGED); fb.sg = ws + OFF_SGB;
        run_gemm(smem, (const bf16_t*)(ws + OFF_OB), (const bf16_t*)(ws + OFF_WB), T, 2048, 1024, fb);
    }
    fast_barrier((unsigned*)(ws + OFF_BAR), 6u);
    {
        FO f; f.x = p.x; f.g2 = p.norm2_g; f.x1 = p.out; f.xg2 = (bf16_t*)(ws + OFF_XG2); f.sumsq = (float*)(ws + OFF_SUMSQ);
        run_gemm(smem, (const bf16_t*)(ws + OFF_MERGED), (const bf16_t*)(ws + OFF_WO), T, 2048, 2048, f);
    }
    fast_barrier((unsigned*)(ws + OFF_BAR), 7u);
    if (DBG_STOP == 6) { dbg_dump(p, ws + OFF_XG2, 0, ws + OFF_MERGED, 0); return; }
    {
        FQ f; f.qp = (bf16_t*)(ws + OFF_QP); f.sumsq = (const float*)(ws + OFF_SUMSQ);
        run_gemm(smem, (const bf16_t*)(ws + OFF_XG2), (const bf16_t*)(ws + OFF_WQ), T, 2048, 2048, f);
    }
    fast_barrier((unsigned*)(ws + OFF_BAR), 8u);
    if (DBG_STOP == 8) { dbg_dump(p, ws + OFF_QP, 0, ws + OFF_QP + 16 * MiB, 0); return; }
    phase_route(p, smem);
    fast_barrier((unsigned*)(ws + OFF_BAR), 9u);
    phase_peer(p);
}

extern "C" void kernel_launch(void* const* d_in, const int* in_sizes, int n_in, void* d_out, int out_size, void* d_ws, size_t ws_size, hipStream_t stream) {
    static int grid_blocks = 0;
    if (!grid_blocks) {
        int dev = 0, cus = 0, per_cu = 0;
        (void)hipGetDevice(&dev);
        (void)hipDeviceGetAttribute(&cus, hipDeviceAttributeMultiprocessorCount, dev);
        (void)hipFuncSetAttribute((const void*)fwd_megakernel, hipFuncAttributeMaxDynamicSharedMemorySize, LDS_BYTES);
        (void)hipOccupancyMaxActiveBlocksPerMultiprocessor(&per_cu, (const void*)fwd_megakernel, 512, LDS_BYTES);
        if (per_cu < 1) per_cu = 1;
        grid_blocks = cus * per_cu;
        if (ws_size < WS_END) fprintf(stderr, "kernel_launch: workspace too small (%zu < %zu)\n", ws_size, (size_t)WS_END);
    }
    Params p{};
    p.x = (const float*)d_in[0]; p.norm1_g = (const float*)d_in[1]; p.w_in = (const float*)d_in[2]; p.fox_f_bias = (const float*)d_in[3]; p.hg_lb_logits = (const float*)d_in[4];
    p.hg_norm_g = (const float*)d_in[5]; p.w_a_up = (const float*)d_in[6]; p.w_b_up = (const float*)d_in[7]; p.w_o = (const float*)d_in[8]; p.norm2_g = (const float*)d_in[9];
    p.peer_wq = (const float*)d_in[10]; p.peer_keys = (const float*)d_in[11]; p.peer_u = (const float*)d_in[12]; p.peer_v = (const float*)d_in[13]; p.norm_f_g = (const float*)d_in[14];
    p.out = (float*)d_out; p.ws = (unsigned char*)d_ws;
    (void)hipMemsetAsync((unsigned char*)d_ws + OFF_BAR, 0, BAR_BYTES, stream);
    void* args[] = {&p};
    hipError_t e = hipLaunchCooperativeKernel((const void*)fwd_megakernel, dim3(grid_blocks), dim3(512), args, LDS_BYTES, stream);
    if (e != hipSuccess) fprintf(stderr, "cooperative launch failed: %s (grid %d)\n", hipGetErrorString(e), grid_blocks);
}
```

```cpp
#include <hip/hip_runtime.h>
#include <hip/hip_cooperative_groups.h>
#include <cstdio>
namespace cg = cooperative_groups;
#define PG8_LAS __attribute__((address_space(3)))
typedef unsigned short bf16_t;
typedef short bf16x8 __attribute__((ext_vector_type(8)));
typedef float f32x4 __attribute__((ext_vector_type(4)));
typedef unsigned u32x4 __attribute__((ext_vector_type(4)));
constexpr int BM = 256, BK = 64, HALF = 128, HTB = HALF * BK * 2  , STAGE_BYTES = 8 * HTB, NXCD = 8, WGM = 8;

__host__ __device__ __forceinline__ int lds_byte(int r, int c) { const int st = (r >> 4) * 2 + (c >> 5), rr = r & 15, cc = c & 31, ob = rr * 64 + cc * 2; return st * 1024 + (ob ^ (((ob >> 9) & 1) << 5)); }
__host__ __device__ __forceinline__ void stage_rc(int b, int& R, int& C) { const int st = b / 1024, sb = b % 1024, swz = sb ^ (((sb >> 9) & 1) << 5); R = (st >> 1) * 16 + swz / 64; C = (st & 1) * 32 + (swz % 64) / 2; }
__host__ __device__ __forceinline__ int perm32(int rho) { const int n = rho >> 4, i = rho & 15; return 8 * (i >> 2) + 4 * n + (i & 3); }

struct Unit { int pm, pn; };
struct Gemm { const bf16_t* A; const bf16_t* Bt; int M, N, K; };

struct StaticOrder {
    int nM, nN, nwg, G, c;
    __host__ __device__ void init(int M, int N, int G_, int c_) { nM = M / BM; nN = N / BM; nwg = nM * nN; G = G_; c = c_; }
    __host__ __device__ bool next(int i, Unit& u) const {
        const long L = (long)i * G + c; if (L >= nwg) return false;
        int wgid = (int)L; { const int q = nwg / NXCD, r = nwg % NXCD, xcd = wgid % NXCD, off = wgid / NXCD; wgid = (xcd < r ? xcd * (q + 1) : r * (q + 1) + (xcd - r) * q) + off; }
        const int nig = WGM * nN, gid = wgid / nig, fm = gid * WGM, gsz = (nM - fm) < WGM ? (nM - fm) : WGM;
        u.pm = fm + ((wgid % nig) % gsz); u.pn = (wgid % nig) / gsz; return true;
    }
    __device__ __forceinline__ void a_ready(const Unit&) const {}
    __device__ __forceinline__ void done(const Unit&) const {}
};
typedef __bf16 bf16x2_t __attribute__((ext_vector_type(2)));
typedef float f32x2_t __attribute__((ext_vector_type(2)));
__device__ __forceinline__ unsigned cvt_pk_bf16(float lo, float hi) { f32x2_t v = {lo, hi}; bf16x2_t r = __builtin_convertvector(v, bf16x2_t); return __builtin_bit_cast(unsigned, r); }
template <class Epi, class Sched>
__device__ __forceinline__ void gemm_phase(PG8_LAS unsigned char* lds, const Gemm g, const Sched& S, const Epi& E) {
    const int tid = threadIdx.x, wid = __builtin_amdgcn_readfirstlane(tid >> 6), lane = tid & 63, wr = wid >> 2, wc = wid & 3, fr = lane & 15, fq = lane >> 4;
    const int K = g.K, nt = K / BK;
    unsigned voffA[2], voffB[2];
#pragma unroll
    for (int i = 0; i < 2; ++i) { int R, C; stage_rc(tid * 16 + i * 8192, R, C); const int Rb = Epi::PERM ? ((R & ~31) + perm32(R & 31)) : R;
        voffA[i] = (unsigned)(R * K + C) * 2u; voffB[i] = (unsigned)(Rb * K + C) * 2u; }
    const size_t kstep = (size_t)(BK * 2);
    const size_t hstep = (size_t)HALF * K * 2;
    const size_t tstep = 2 * hstep;
    const unsigned ldsw = (unsigned)wid * 1024u;
    const int aoff = lds_byte(wr * 64 + fr, fq * 8), boff = lds_byte(wc * 32 + fr, fq * 8);
#define PG8_SA(b, h) (((b) * 2 + (h)) * HTB)
#define PG8_SB(b, h) ((4 + (b) * 2 + (h)) * HTB)
#define PG8_STAGE(bufoff, gbase, voff) do { _Pragma("unroll") for (int _i = 0; _i < 2; ++_i) \
        __builtin_amdgcn_global_load_lds((const unsigned*)((const char*)(gbase) + (voff)[_i]), (PG8_LAS unsigned*)(lds + (bufoff) + ldsw + _i * 8192), 16, 0, 0); } while (0)
#define PG8_LDA(dst, b, h) do { _Pragma("unroll") for (int m = 0; m < 4; ++m) _Pragma("unroll") for (int k = 0; k < 2; ++k) dst[m][k] = *(const PG8_LAS bf16x8*)(lds + PG8_SA(b, h) + aoff + m * 2048 + k * 1024); } while (0)
#define PG8_LDB(dst, b, h) do { _Pragma("unroll") for (int n = 0; n < 2; ++n) _Pragma("unroll") for (int k = 0; k < 2; ++k) dst[n][k] = *(const PG8_LAS bf16x8*)(lds + PG8_SB(b, h) + boff + n * 2048 + k * 1024); } while (0)
#define PG8_MMA(ai, bj, At, Bt) do { __builtin_amdgcn_s_setprio(1); _Pragma("unroll") for (int m = 0; m < 4; ++m) _Pragma("unroll") for (int n = 0; n < 2; ++n) _Pragma("unroll") for (int k = 0; k < 2; ++k) \
        acc[ai][bj][m][n] = __builtin_amdgcn_mfma_f32_16x16x32_bf16(Bt[n][k], At[m][k], acc[ai][bj][m][n], 0, 0, 0); __builtin_amdgcn_s_setprio(0); } while (0)
#define PG8_WAIT_V(n) asm volatile("s_waitcnt vmcnt(" #n ")" ::: "memory")
#define PG8_WAIT_L(n) asm volatile("s_waitcnt lgkmcnt(" #n ")" ::: "memory")
#define PG8_BAR __builtin_amdgcn_s_barrier()
#define PG8_SCHED __builtin_amdgcn_sched_barrier(0)
    Unit cur, nxt; int ui = 0;
    if (!S.next(0, cur)) return;
    f32x4 acc[2][2][4][2];
#pragma unroll
    for (int a = 0; a < 2; ++a)
#pragma unroll
        for (int b = 0; b < 2; ++b)
#pragma unroll
            for (int m = 0; m < 4; ++m)
#pragma unroll
                for (int n = 0; n < 2; ++n) acc[a][b][m][n] = (f32x4){0.f, 0.f, 0.f, 0.f};
    bf16x8 At[4][2], B0[2][2], B1[2][2];
    const char* cA = (const char*)g.A + (size_t)cur.pm * tstep; const char* cB = (const char*)g.Bt + (size_t)cur.pn * tstep;
    S.a_ready(cur);
    PG8_STAGE(PG8_SB(0, 0), cB, voffB); PG8_STAGE(PG8_SA(0, 0), cA, voffA); PG8_STAGE(PG8_SB(0, 1), cB + hstep, voffB); PG8_STAGE(PG8_SA(0, 1), cA + hstep, voffA);
    if (wr == 1) PG8_BAR;
    PG8_WAIT_V(4); PG8_BAR;
    PG8_STAGE(PG8_SB(1, 0), cB + kstep, voffB); PG8_STAGE(PG8_SA(1, 0), cA + kstep, voffA); PG8_STAGE(PG8_SB(1, 1), cB + hstep + kstep, voffB);
    PG8_WAIT_V(6); PG8_BAR;
    for (;;) {
        const bool has_next = S.next(ui + 1, nxt);
        const char* nA = has_next ? (const char*)g.A + (size_t)nxt.pm * tstep : cA; const char* nB = has_next ? (const char*)g.Bt + (size_t)nxt.pn * tstep : cB;
        for (int t = 0; t < nt; t += 2) {
            const bool last = (t == nt - 2);
            const char* a1 = cA + (size_t)(t + 1) * kstep;
            const char* a2 = last ? nA : cA + (size_t)(t + 2) * kstep; const char* b2 = last ? nB : cB + (size_t)(t + 2) * kstep;
            const char* a3 = a2 + kstep; const char* b3 = b2 + kstep;
            if (last && has_next) S.a_ready(nxt);
            PG8_LDB(B0, 0, 0); PG8_SCHED; PG8_LDA(At, 0, 0); PG8_STAGE(PG8_SA(1, 1), a1 + hstep, voffA);
            PG8_WAIT_L(8); PG8_BAR; PG8_WAIT_L(0); PG8_MMA(0, 0, At, B0); PG8_BAR; PG8_SCHED;
            PG8_LDB(B1, 0, 1); PG8_STAGE(PG8_SB(0, 0), b2, voffB);
            PG8_BAR; PG8_WAIT_L(0); PG8_MMA(0, 1, At, B1); PG8_BAR;
            PG8_LDA(At, 0, 1); PG8_STAGE(PG8_SA(0, 0), a2, voffA);
            PG8_BAR; PG8_WAIT_L(0); PG8_MMA(1, 0, At, B0); PG8_BAR; PG8_SCHED;
            PG8_STAGE(PG8_SB(0, 1), b2 + hstep, voffB);
            PG8_WAIT_V(6); PG8_BAR; PG8_MMA(1, 1, At, B1); PG8_BAR;
            PG8_LDB(B0, 1, 0); PG8_SCHED; PG8_LDA(At, 1, 0); PG8_STAGE(PG8_SA(0, 1), a2 + hstep, voffA);
            PG8_WAIT_L(8); PG8_BAR; PG8_WAIT_L(0); PG8_MMA(0, 0, At, B0); PG8_BAR; PG8_SCHED;
            PG8_LDB(B1, 1, 1); PG8_STAGE(PG8_SB(1, 0), b3, voffB);
            PG8_BAR; PG8_WAIT_L(0); PG8_MMA(0, 1, At, B1); PG8_BAR;
            PG8_LDA(At, 1, 1); PG8_STAGE(PG8_SA(1, 0), a3, voffA);
            PG8_BAR; PG8_WAIT_L(0); PG8_MMA(1, 0, At, B0); PG8_BAR; PG8_SCHED;
            PG8_STAGE(PG8_SB(1, 1), b3 + hstep, voffB);
            PG8_WAIT_V(6); PG8_BAR; PG8_MMA(1, 1, At, B1); PG8_BAR;
        }
        if constexpr (!Epi::AFTER_DRAIN) { E(acc, cur, wr, wc, fr, fq); S.done(cur); }
        if (!has_next) break;
#pragma unroll
        for (int a = 0; a < 2; ++a)
#pragma unroll
            for (int b = 0; b < 2; ++b)
#pragma unroll
                for (int m = 0; m < 4; ++m)
#pragma unroll
                    for (int n = 0; n < 2; ++n) acc[a][b][m][n] = (f32x4){0.f, 0.f, 0.f, 0.f};
        cur = nxt; cA = nA; cB = nB; ++ui;
    }
    PG8_WAIT_V(0);
    if (wr == 0) PG8_BAR;
    PG8_BAR;
    if constexpr (Epi::AFTER_DRAIN) { E.fused(acc, cur, wr, wc, fr, fq, lds, wid, lane); S.done(cur); }
#undef PG8_SA
#undef PG8_SB
#undef PG8_STAGE
#undef PG8_LDA
#undef PG8_LDB
#undef PG8_MMA
#undef PG8_WAIT_V
#undef PG8_WAIT_L
#undef PG8_BAR
#undef PG8_SCHED
}
#define LAS PG8_LAS
typedef unsigned u32x2 __attribute__((ext_vector_type(2)));
typedef float f32x2 __attribute__((ext_vector_type(2)));

constexpr int T = 8192, D = 2048, NZ = 11264, NIN_SRC = 11272;
constexpr float EPS = 1e-6f;
constexpr size_t MiB = 1ull << 20;
constexpr size_t OFF_WIN = 0;
constexpr size_t OFF_QIN = 44 * MiB;
constexpr size_t OFF_V = 60 * MiB;
constexpr size_t OFF_FQ = 76 * MiB, OFF_FK = 92 * MiB, OFF_FV = 108 * MiB;
constexpr size_t OFF_LT = 124 * MiB;
constexpr size_t OFF_WA = 156 * MiB;
constexpr size_t OFF_WB = 160 * MiB;
constexpr size_t OFF_WO = 164 * MiB;
constexpr size_t OFF_WQ = 172 * MiB;
constexpr size_t OFF_KEYS = 180 * MiB;
constexpr size_t OFF_LOGFA = 180 * MiB + 512 * 1024;
constexpr size_t OFF_CFOX = OFF_LOGFA + 256 * 1024;
constexpr size_t OFF_BQ = OFF_CFOX + 256 * 1024;
constexpr size_t OFF_DEC = OFF_BQ + 1024;
constexpr size_t OFF_USC = 181 * MiB + 768 * 1024;
constexpr size_t OFF_VSC = 181 * MiB + 832 * 1024;
constexpr size_t OFF_BAR = 181 * MiB + 896 * 1024;
constexpr size_t BAR_BYTES = 8192;
constexpr size_t OFF_NM = 181 * MiB + 904 * 1024;
constexpr size_t OFF_SUMSQ = 182 * MiB;
constexpr size_t OFF_SGATE = 183 * MiB;
constexpr size_t OFF_SGA = 199 * MiB;
constexpr size_t OFF_SGB = 215 * MiB;
constexpr size_t OFF_V8 = 231 * MiB;
constexpr size_t OFF_ST = 263 * MiB;
constexpr size_t OFF_OINTRA = 295 * MiB;
constexpr size_t OFF_QE = 327 * MiB;
constexpr size_t OFF_YA = 343 * MiB;
constexpr size_t OFF_OB = 359 * MiB;
constexpr size_t OFF_MERGED = 375 * MiB;
constexpr size_t OFF_XG2 = 407 * MiB;
constexpr size_t OFF_QP = 439 * MiB;
constexpr size_t OFF_IDX = 471 * MiB;
constexpr size_t OFF_GATE = 475 * MiB;
constexpr size_t OFF_U8 = 479 * MiB;
constexpr size_t WS_END = 511 * MiB;
constexpr size_t OUT_LOGF = 32 * MiB;
constexpr int LDS_BYTES = 131072;

struct Params {
    const float *x, *norm1_g, *w_in, *fox_f_bias, *hg_lb_logits, *hg_norm_g, *w_a_up, *w_b_up, *w_o, *norm2_g, *peer_wq, *peer_keys, *peer_u, *peer_v, *norm_f_g;
    float* out; unsigned char* ws;
};

__device__ __forceinline__ float bf2f(bf16_t b) { return __uint_as_float(((unsigned)b) << 16); }
__device__ __forceinline__ float bflo(unsigned u) { return __uint_as_float(u << 16); }
__device__ __forceinline__ float bfhi(unsigned u) { return __uint_as_float(u & 0xffff0000u); }
__device__ __forceinline__ bf16_t f2bf(float f) { return (bf16_t)(cvt_pk_bf16(f, 0.f) & 0xffffu); }
__device__ __forceinline__ float wave_sum(float v) {
#pragma unroll
    for (int o = 32; o > 0; o >>= 1) v += __shfl_xor(v, o);
    return v;
}
__device__ __forceinline__ float sigmoidf_(float x) { return 1.f / (1.f + __expf(-x)); }
__device__ __forceinline__ float siluf_(float x) { return x / (1.f + __expf(-x)); }
__device__ __forceinline__ f32x4 mfma16(bf16x8 a, bf16x8 b, f32x4 c) { return __builtin_amdgcn_mfma_f32_16x16x32_bf16(a, b, c, 0, 0, 0); }
__device__ __forceinline__ unsigned cvt_pk_bf16_asm(float lo, float hi) { unsigned r; asm volatile("v_cvt_pk_bf16_f32 %0, %1, %2" : "=v"(r) : "v"(lo), "v"(hi)); return r; }
__device__ __forceinline__ u32x4 pack8(const float* v) { u32x4 o; o[0] = cvt_pk_bf16_asm(v[0], v[1]); o[1] = cvt_pk_bf16_asm(v[2], v[3]); o[2] = cvt_pk_bf16_asm(v[4], v[5]); o[3] = cvt_pk_bf16_asm(v[6], v[7]); return o; }

__device__ __forceinline__ float row_rstd(const float* ssp, int row) {
    const f32x4* q = (const f32x4*)(ssp + (size_t)row * 32); float s = 0.f;
#pragma unroll
    for (int i = 0; i < 8; ++i) { const f32x4 v = q[i]; s += (v[0] + v[1]) + (v[2] + v[3]); }
    return rsqrtf(s * (1.f / 2048.f) + EPS);
}
template <class F> struct EpiRow {
    static constexpr bool PERM = true, AFTER_DRAIN = false;
    F f;
    __device__ __forceinline__ void operator()(const f32x4 (&acc)[2][2][4][2], const Unit& u, int wr, int wc, int fr, int fq) const {
        const int row0 = u.pm * BM + wr * 64 + fr, col0 = u.pn * BM + wc * 32 + 8 * fq;
        asm volatile("s_nop 15\n\ts_nop 15" ::: "memory");
#pragma unroll
        for (int ai = 0; ai < 2; ++ai)
#pragma unroll
            for (int m = 0; m < 4; ++m) {
                const int row = row0 + ai * HALF + m * 16;
                float v[2][8];
#pragma unroll
                for (int bj = 0; bj < 2; ++bj)
#pragma unroll
                    for (int e = 0; e < 4; ++e) { v[bj][e] = acc[ai][bj][m][0][e]; v[bj][4 + e] = acc[ai][bj][m][1][e]; }
                f(row, col0, v[0], col0 + HALF, v[1], u);
            }
    }
};
__device__ __forceinline__ void st8bf(bf16_t* p, const float* v) { *(u32x4*)p = pack8(v); }

struct FZ {
    bf16_t *fq, *fk, *fv, *qin, *v, *sgate; unsigned char *sga, *sgb; float* logfo; const float* lbl;
    __device__ __forceinline__ void one(int row, int c, const float* a) const {
        const int reg = c >> 10, lc = c & 1023; float o[8];
        const size_t r1 = (size_t)row * 1024 + lc;
        if (reg == 0) {
#pragma unroll
            for (int e = 0; e < 8; ++e) o[e] = a[e] * 0.08838834764831845f;
            st8bf(fq + r1, o);
        } else if (reg == 1) { st8bf(fk + r1, a);
        } else if (reg == 2) { st8bf(fv + r1, a);
        } else if (reg == 3) {
#pragma unroll
            for (int e = 0; e < 8; ++e) o[e] = siluf_(a[e]);
            st8bf(qin + r1, o);
        } else if (reg == 4) {
            const f32x4 l0a = *(const f32x4*)(lbl + lc), l0b = *(const f32x4*)(lbl + lc + 4), l1a = *(const f32x4*)(lbl + 1024 + lc), l1b = *(const f32x4*)(lbl + 1024 + lc + 4);
#pragma unroll
            for (int e = 0; e < 8; ++e) { const float l0 = e < 4 ? l0a[e & 3] : l0b[e & 3], l1 = e < 4 ? l1a[e & 3] : l1b[e & 3];
                const float lb = 1.f / (1.f + __expf(l1 - l0)); const float f = lb + (1.f - lb) * sigmoidf_(a[e]); o[e] = logf(f); }
            *(f32x4*)(logfo + r1) = (f32x4){o[0], o[1], o[2], o[3]}; *(f32x4*)(logfo + r1 + 4) = (f32x4){o[4], o[5], o[6], o[7]};
        } else if (reg == 5) { st8bf(v + r1, a);
        } else if (reg == 6) {
#pragma unroll
            for (int e = 0; e < 8; ++e) o[e] = siluf_(a[e]);
            st8bf(sgate + r1, o);
        } else {
#pragma unroll
            for (int e = 0; e < 8; ++e) o[e] = sigmoidf_(a[e]);
            u32x2 pk; pk[0] = (unsigned)(o[0] * 255.f + 0.5f) | ((unsigned)(o[1] * 255.f + 0.5f) << 8) | ((unsigned)(o[2] * 255.f + 0.5f) << 16) | ((unsigned)(o[3] * 255.f + 0.5f) << 24);
            pk[1] = (unsigned)(o[4] * 255.f + 0.5f) | ((unsigned)(o[5] * 255.f + 0.5f) << 8) | ((unsigned)(o[6] * 255.f + 0.5f) << 16) | ((unsigned)(o[7] * 255.f + 0.5f) << 24);
            if (reg < 9) *(u32x2*)(sga + (size_t)row * 2048 + (c - 7168)) = pk; else *(u32x2*)(sgb + (size_t)row * 2048 + (c - 9216)) = pk;
        }
    }
    __device__ __forceinline__ void operator()(int row, int cA, const float* vA, int cB, const float* vB, const Unit&) const { one(row, cA, vA); one(row, cB, vB); }
};
struct FA {
    bf16_t* merged; const unsigned char* sg;
    __device__ __forceinline__ void one(int row, int c, const float* a) const {
        const size_t o = (size_t)row * 2048 + c; const u32x2 g = *(const u32x2*)(sg + o); float r[8];
#pragma unroll
        for (int e = 0; e < 8; ++e) r[e] = a[e] * ((float)((g[e >> 2] >> (8 * (e & 3))) & 255u) * (1.f / 255.f));
        st8bf(merged + o, r);
    }
    __device__ __forceinline__ void operator()(int row, int cA, const float* vA, int cB, const float* vB, const Unit&) const { one(row, cA, vA); one(row, cB, vB); }
};
struct FB {
    bf16_t* merged; const unsigned char* sg;
    __device__ __forceinline__ void one(int row, int c, const float* a) const {
        const size_t o = (size_t)row * 2048 + c; const u32x2 g = *(const u32x2*)(sg + o); const u32x4 mm = *(const u32x4*)(merged + o); float r[8];
#pragma unroll
        for (int e = 0; e < 8; ++e) r[e] = ((e & 1) ? bfhi(mm[e >> 1]) : bflo(mm[e >> 1])) + a[e] * ((float)((g[e >> 2] >> (8 * (e & 3))) & 255u) * (1.f / 255.f));
        st8bf(merged + o, r);
    }
    __device__ __forceinline__ void operator()(int row, int cA, const float* vA, int cB, const float* vB, const Unit&) const { one(row, cA, vA); one(row, cB, vB); }
};
struct FO {
    const float* x; const float* g2; float* x1; bf16_t* xg2; float* sumsq;
    __device__ __forceinline__ float one(int row, int c, const float* a) const {
        const size_t o = (size_t)row * 2048 + c; const f32x4 xa = *(const f32x4*)(x + o), xb = *(const f32x4*)(x + o + 4), ga = *(const f32x4*)(g2 + c), gb = *(const f32x4*)(g2 + c + 4);
        float r[8], s = 0.f, w[8];
#pragma unroll
        for (int e = 0; e < 8; ++e) { r[e] = a[e] + (e < 4 ? xa[e & 3] : xb[e & 3]); s += r[e] * r[e]; w[e] = r[e] * (e < 4 ? ga[e & 3] : gb[e & 3]); }
        *(f32x4*)(x1 + o) = (f32x4){r[0], r[1], r[2], r[3]}; *(f32x4*)(x1 + o + 4) = (f32x4){r[4], r[5], r[6], r[7]};
        st8bf(xg2 + o, w); return s;
    }
    __device__ __forceinline__ void operator()(int row, int cA, const float* vA, int cB, const float* vB, const Unit& u) const {
        float s = one(row, cA, vA) + one(row, cB, vB);
        s += __shfl_xor(s, 16); s += __shfl_xor(s, 32);
        if ((threadIdx.x & 63) < 16) sumsq[(size_t)row * 32 + u.pn * 4 + ((threadIdx.x >> 6) & 3)] = s;
    }
};
struct FQ {
    bf16_t* qp; const float* sumsq;
    __device__ __forceinline__ void operator()(int row, int cA, const float* vA, int cB, const float* vB, const Unit&) const {
        const float rs = row_rstd(sumsq, row); float r[8];
#pragma unroll
        for (int e = 0; e < 8; ++e) r[e] = vA[e] * rs;
        st8bf(qp + (size_t)row * 2048 + cA, r);
#pragma unroll
        for (int e = 0; e < 8; ++e) r[e] = vB[e] * rs;
        st8bf(qp + (size_t)row * 2048 + cB, r);
    }
};
template <class F> __device__ __forceinline__ void run_gemm(unsigned char* smem, const bf16_t* A, const bf16_t* Bt, int M, int N, int K, const F& f) {
    Gemm g; g.A = A; g.Bt = Bt; g.M = M; g.N = N; g.K = K;
    StaticOrder S; S.init(M, N, (int)gridDim.x, (int)blockIdx.x);
    EpiRow<F> E{f};
    gemm_phase<EpiRow<F>, StaticOrder>((LAS unsigned char*)smem, g, S, E);
    __syncthreads();
}
__device__ __forceinline__ void transpose_tile(const float* src, int ldsrc, int srccol0, bf16_t* dst, int K, int k0, int n0, float* tl) {
    const int tid = threadIdx.x, j4 = tid & 31, i = tid >> 5;
    f32x4 v[4];
#pragma unroll
    for (int r = 0; r < 4; ++r) v[r] = *(const f32x4*)(src + (size_t)(k0 + r * 16 + i) * ldsrc + srccol0 + j4 * 4);
#pragma unroll
    for (int r = 0; r < 4; ++r) { const int k = r * 16 + i;
#pragma unroll
        for (int e = 0; e < 4; ++e) tl[(j4 * 4 + e) * 65 + (k ^ (j4 >> 3))] = v[r][e]; }
    __syncthreads();
    const int n = tid >> 2, kc = tid & 3; float o[16];
#pragma unroll
    for (int e = 0; e < 16; ++e) o[e] = tl[n * 65 + ((kc * 16 + e) ^ (n >> 5))];
    st8bf(dst + (size_t)(n0 + n) * K + k0 + kc * 16, o); st8bf(dst + (size_t)(n0 + n) * K + k0 + kc * 16 + 8, o + 8);
    __syncthreads();
}
__device__ __forceinline__ void cvt_stream(const float* src, bf16_t* dst, size_t n) {
    const size_t nthr = (size_t)gridDim.x * 512, gt = (size_t)blockIdx.x * 512 + threadIdx.x;
    for (size_t i = gt * 8; i < n; i += nthr * 8) {
        const f32x4 a = *(const f32x4*)(src + i), b = *(const f32x4*)(src + i + 4);
        float v[8] = {a[0], a[1], a[2], a[3], b[0], b[1], b[2], b[3]};
        st8bf(dst + i, v);
    }
}
__device__ void phase_prep(const Params& p, unsigned char* smem) {
    const int tid = threadIdx.x, wid = tid >> 6, lane = tid & 63, nb = gridDim.x, b = blockIdx.x;
    unsigned char* ws = p.ws;
    float* tl = (float*)smem;
    float* wff = (float*)(smem + 36864);
    {
        for (int it = b; it < 32 * 88; it += nb) { const int kt = it / 88, nt = it % 88; const int n0 = nt * 128; transpose_tile(p.w_in, NIN_SRC, n0 < 3072 ? n0 : n0 + 8, (bf16_t*)(ws + OFF_WIN), 2048, kt * 64, n0, tl); }
        for (int it = b; it < 16 * 16; it += nb) { const int kt = it / 16, nt = it % 16; transpose_tile(p.w_a_up, 2048, nt * 128, (bf16_t*)(ws + OFF_WA), 1024, kt * 64, nt * 128, tl); }
        for (int it = b; it < 16 * 16; it += nb) { const int kt = it / 16, nt = it % 16; transpose_tile(p.w_b_up, 2048, nt * 128, (bf16_t*)(ws + OFF_WB), 1024, kt * 64, nt * 128, tl); }
        for (int it = b; it < 32 * 16; it += nb) { const int kt = it / 16, nt = it % 16; transpose_tile(p.w_o, 2048, nt * 128, (bf16_t*)(ws + OFF_WO), 2048, kt * 64, nt * 128, tl); }
        for (int it = b; it < 32 * 16; it += nb) { const int kt = it / 16, nt = it % 16; transpose_tile(p.peer_wq, 2048, nt * 128, (bf16_t*)(ws + OFF_WQ), 2048, kt * 64, nt * 128, tl); }
    }
    {
        f32x4 wa[4], wb[4];
#pragma unroll
        for (int u = 0; u < 4; ++u) { const float* src = p.w_in + (size_t)(tid + u * 512) * NIN_SRC + 3072; wa[u] = *(const f32x4*)src; wb[u] = *(const f32x4*)(src + 4); }
#pragma unroll
        for (int u = 0; u < 4; ++u) { const int d = tid + u * 512;
#pragma unroll
            for (int hh = 0; hh < 4; ++hh) { wff[hh * 2048 + d] = wa[u][hh]; wff[(4 + hh) * 2048 + d] = wb[u][hh]; } }
    }
    __syncthreads();
    {
        bf16_t* h = (bf16_t*)p.out; float* logfa = (float*)(ws + OFF_LOGFA);
        const bool b5 = (lane & 32) != 0, b4 = (lane & 16) != 0, b3 = (lane & 8) != 0;
        f32x4 xn[8];
        { const int row = b * 8 + wid; if (row < T) {
#pragma unroll
            for (int i = 0; i < 8; ++i) xn[i] = *(const f32x4*)(p.x + (size_t)row * D + i * 256 + lane * 4); } }
#pragma unroll 1
        for (int row = b * 8 + wid; row < T; row += nb * 8) {
            f32x4 xv[8]; float ss = 0.f;
#pragma unroll
            for (int i = 0; i < 8; ++i) { xv[i] = xn[i]; ss += xv[i][0] * xv[i][0] + xv[i][1] * xv[i][1] + xv[i][2] * xv[i][2] + xv[i][3] * xv[i][3]; }
            { const int rown = row + nb * 8; if (rown < T) {
#pragma unroll
                for (int i = 0; i < 8; ++i) xn[i] = *(const f32x4*)(p.x + (size_t)rown * D + i * 256 + lane * 4); } }
            ss = wave_sum(ss); const float rs = rsqrtf(ss * (1.f / 2048.f) + EPS);
            float fa[8] = {0, 0, 0, 0, 0, 0, 0, 0};
#pragma unroll
            for (int i = 0; i < 8; ++i) {
                const f32x4 g = *(const f32x4*)(p.norm1_g + i * 256 + lane * 4);
                f32x4 hv; hv[0] = xv[i][0] * rs * g[0]; hv[1] = xv[i][1] * rs * g[1]; hv[2] = xv[i][2] * rs * g[2]; hv[3] = xv[i][3] * rs * g[3];
                u32x2 o; o[0] = cvt_pk_bf16_asm(hv[0], hv[1]); o[1] = cvt_pk_bf16_asm(hv[2], hv[3]);
                *(u32x2*)(h + (size_t)row * D + i * 256 + lane * 4) = o;
#pragma unroll
                for (int hh = 0; hh < 8; ++hh) { const f32x4 w = *(const f32x4*)(wff + hh * 2048 + i * 256 + lane * 4); fa[hh] += hv[0] * w[0] + hv[1] * w[1] + hv[2] * w[2] + hv[3] * w[3]; }
            }
            float r4[4], r2[2];
#pragma unroll
            for (int i = 0; i < 4; ++i) { const float mine = b5 ? fa[4 + i] : fa[i], oth = b5 ? fa[i] : fa[4 + i]; r4[i] = mine + __shfl_xor(oth, 32); }
#pragma unroll
            for (int i = 0; i < 2; ++i) { const float mine = b4 ? r4[2 + i] : r4[i], oth = b4 ? r4[i] : r4[2 + i]; r2[i] = mine + __shfl_xor(oth, 16); }
            float v1 = (b3 ? r2[1] : r2[0]) + __shfl_xor(b3 ? r2[0] : r2[1], 8); v1 += __shfl_xor(v1, 4); v1 += __shfl_xor(v1, 2); v1 += __shfl_xor(v1, 1);
            if ((lane & 7) == 0) { const int hh = lane >> 3; const float z = v1 + p.fox_f_bias[hh]; logfa[(size_t)row * 8 + hh] = fminf(z, 0.f) - log1pf(__expf(-fabsf(z))); }
        }
    }
    cvt_stream(p.peer_keys, (bf16_t*)(ws + OFF_KEYS), (size_t)8 * 2 * 128 * 128);
}
__device__ void hg_local_item(const Params& p, unsigned char* smem, int item) {
    const int tid = threadIdx.x, wid = tid >> 6, lane = tid & 63, r = lane & 15, q4 = lane >> 4;
    unsigned char* ws = p.ws;
    const int c = item >> 3, h = item & 7, t0 = c * 64;
    bf16_t* qeS = (bf16_t*)smem;
    bf16_t* keS = qeS + 64 * 136;
    bf16_t* kdT = keS + 64 * 136;
    bf16_t* vT = kdT + 128 * 72;
    bf16_t* Am = vT + 128 * 72;
    float* segsum = (float*)(Am + 64 * 72);
    const float* logf = (const float*)((const unsigned char*)p.out + OUT_LOGF); const bf16_t* qin = (const bf16_t*)(ws + OFF_QIN); const bf16_t* vin = (const bf16_t*)(ws + OFF_V);
    bf16_t* qeG = (bf16_t*)(ws + OFF_QE); float* dec = (float*)(ws + OFF_DEC); float* ointra = (float*)(ws + OFF_OINTRA); bf16_t* LT = (bf16_t*)(ws + OFF_LT);
    float* nmS = segsum + 512;
    {
        const bf16_t* fqp = (const bf16_t*)(ws + OFF_FQ); const bf16_t* fkp = (const bf16_t*)(ws + OFF_FK);
        const size_t o = (size_t)(t0 + (tid >> 3)) * 1024 + h * 128 + (tid & 7) * 16; float sa = 0.f, sb = 0.f;
#pragma unroll
        for (int u = 0; u < 2; ++u) { const u32x4 a = *(const u32x4*)(fqp + o + u * 8), bq = *(const u32x4*)(fkp + o + u * 8);
#pragma unroll
            for (int e = 0; e < 4; ++e) { sa += bflo(a[e]) * bflo(a[e]) + bfhi(a[e]) * bfhi(a[e]); sb += bflo(bq[e]) * bflo(bq[e]) + bfhi(bq[e]) * bfhi(bq[e]); } }
#pragma unroll
        for (int o2 = 1; o2 < 8; o2 <<= 1) { sa += __shfl_xor(sa, o2); sb += __shfl_xor(sb, o2); }
#pragma unroll
        for (int o2 = 8; o2 < 64; o2 <<= 1) { sa = fmaxf(sa, __shfl_xor(sa, o2)); sb = fmaxf(sb, __shfl_xor(sb, o2)); }
        if (lane == 0) { nmS[wid] = sa; nmS[8 + wid] = sb; }
    }
    {
        const int k = tid & 127, seg = tid >> 7;
        float lf[16], bl[16]; float run = 0.f; bf16_t qv[16], vv[16];
        const size_t base = (size_t)(t0 + seg * 16) * 1024 + h * 128 + k;
#pragma unroll
        for (int i = 0; i < 16; ++i) { lf[i] = logf[base + (size_t)i * 1024]; qv[i] = qin[base + (size_t)i * 1024]; vv[i] = vin[base + (size_t)i * 1024]; }
        __builtin_amdgcn_sched_barrier(0);
#pragma unroll
        for (int i = 0; i < 16; ++i) { run += lf[i]; bl[i] = run; }
        segsum[seg * 128 + k] = run;
        __syncthreads();
        float off = 0.f, tot = 0.f;
#pragma unroll
        for (int s = 0; s < 4; ++s) { const float v = segsum[s * 128 + k]; off += (s < seg) ? v : 0.f; tot += v; }
#pragma unroll
        for (int i = 0; i < 16; ++i) {
            const int t = seg * 16 + i; const float bb = bl[i] + off; const float kk = 1.f - __expf(lf[i]);
            const float q = bf2f(qv[i]);
            const bf16_t qe = f2bf(q * __expf(bb));
            qeS[t * 136 + k] = qe; qeG[base + (size_t)i * 1024] = qe;
            keS[t * 136 + k] = f2bf(kk * __expf(-bb));
            kdT[k * 72 + t] = f2bf(kk * __expf(tot - bb));
            vT[k * 72 + t] = vv[i];
        }
        if (seg == 0) dec[item * 128 + k] = __expf(tot);
        if (tid == 0) { float a = 0.f, b2 = 0.f;
#pragma unroll
            for (int w = 0; w < 8; ++w) { a = fmaxf(a, nmS[w]); b2 = fmaxf(b2, nmS[8 + w]); }
            float* nm = (float*)(ws + OFF_NM); nm[item * 2] = a; nm[item * 2 + 1] = b2; }
    }
    __syncthreads();
    {
        const int tt = wid >> 1;
#pragma unroll
        for (int u = 0; u < 2; ++u) {
            const int st = (wid & 1) * 2 + u;
            f32x4 acc = {0.f, 0.f, 0.f, 0.f};
            if (st <= tt) {
#pragma unroll
                for (int ks = 0; ks < 4; ++ks) acc = mfma16(*(const bf16x8*)(qeS + (tt * 16 + r) * 136 + ks * 32 + q4 * 8), *(const bf16x8*)(keS + (st * 16 + r) * 136 + ks * 32 + q4 * 8), acc);
            }
#pragma unroll
            for (int j = 0; j < 4; ++j) { const int t = tt * 16 + q4 * 4 + j, s = st * 16 + r; Am[t * 72 + s] = f2bf((s <= t) ? acc[j] : 0.f); }
        }
    }
    __syncthreads();
    {
        const int tt = wid & 3;
#pragma unroll
        for (int u = 0; u < 4; ++u) {
            const int vt = (wid >> 2) * 4 + u; f32x4 acc = {0.f, 0.f, 0.f, 0.f};
#pragma unroll
            for (int ks = 0; ks < 2; ++ks) acc = mfma16(*(const bf16x8*)(vT + (vt * 16 + r) * 72 + ks * 32 + q4 * 8), *(const bf16x8*)(Am + (tt * 16 + r) * 72 + ks * 32 + q4 * 8), acc);
            *(f32x4*)(ointra + (size_t)(t0 + tt * 16 + r) * 1024 + h * 128 + vt * 16 + q4 * 4) = acc;
        }
    }
    {
        const int vt = wid;
#pragma unroll
        for (int kt = 0; kt < 8; ++kt) {
            f32x4 acc = {0.f, 0.f, 0.f, 0.f};
#pragma unroll
            for (int ks = 0; ks < 2; ++ks) acc = mfma16(*(const bf16x8*)(kdT + (kt * 16 + r) * 72 + ks * 32 + q4 * 8), *(const bf16x8*)(vT + (vt * 16 + r) * 72 + ks * 32 + q4 * 8), acc);
            u32x2 o; o[0] = cvt_pk_bf16(acc[0], acc[1]); o[1] = cvt_pk_bf16(acc[2], acc[3]);
            *(u32x2*)(LT + (size_t)item * 16384 + (vt * 16 + r) * 128 + kt * 16 + q4 * 4) = o;
        }
    }
    __syncthreads();
}
__device__ void fox_scan_item(const Params& p, unsigned char* smem, int h) {
    const int tid = threadIdx.x, wid = tid >> 6, lane = tid & 63;
    unsigned char* ws = p.ws;
    const float* logfa = (const float*)(ws + OFF_LOGFA); float* cf = (float*)(ws + OFF_CFOX) + (size_t)h * T;
    float* wtot = (float*)smem;
    float loc[16]; float run = 0.f;
#pragma unroll
    for (int i = 0; i < 16; ++i) { run += logfa[(size_t)(tid * 16 + i) * 8 + h]; loc[i] = run; }
    float inc = run;
#pragma unroll
    for (int o = 1; o < 64; o <<= 1) { const float n = __shfl_up(inc, o); if (lane >= o) inc += n; }
    if (lane == 63) wtot[wid] = inc;
    __syncthreads();
    float off = 0.f;
#pragma unroll
    for (int w = 0; w < 8; ++w) off += (w < wid) ? wtot[w] : 0.f;
    off += inc - run;
#pragma unroll
    for (int i = 0; i < 16; ++i) cf[tid * 16 + i] = off + loc[i];
    __syncthreads();
}
__device__ void phase_hg_local(const Params& p, unsigned char* smem) {
    for (int it = blockIdx.x; it < 8 + 1024; it += gridDim.x) { if (it < 8) fox_scan_item(p, smem, it); else hg_local_item(p, smem, it - 8); }
}
__device__ void attn_item(const Params& p, unsigned char* smem, int item) {
    const int tid = threadIdx.x, wid = tid >> 6, lane = tid & 63, r = lane & 15, q4 = lane >> 4;
    unsigned char* ws = p.ws;
    const int h = item & 7, qb = item >> 3, t0 = qb * 128, tw = t0 + wid * 16;
    bf16_t* Ks = (bf16_t*)smem;
    bf16_t* vT = Ks + 64 * 136;
    float* csS = (float*)(vT + 128 * 72);
    const bf16_t* fq = (const bf16_t*)(ws + OFF_FQ); const bf16_t* fk = (const bf16_t*)(ws + OFF_FK); const bf16_t* fv = (const bf16_t*)(ws + OFF_FV);
    const float* cf = (const float*)(ws + OFF_CFOX) + (size_t)h * T; bf16_t* ya = (bf16_t*)(ws + OFF_YA);
    bf16x8 qf[4];
#pragma unroll
    for (int ks = 0; ks < 4; ++ks) qf[ks] = *(const bf16x8*)(fq + (size_t)(tw + r) * 1024 + h * 128 + ks * 32 + q4 * 8);
    const int trow = tw + r; const float ct = cf[trow];
    float bqk;
    {
        float a = 0.f, b2 = 0.f;
        if (tid < 128) { const float* nm = (const float*)(ws + OFF_NM) + (size_t)(tid * 8 + h) * 2; a = nm[0]; b2 = nm[1]; }
#pragma unroll
        for (int o2 = 1; o2 < 64; o2 <<= 1) { a = fmaxf(a, __shfl_xor(a, o2)); b2 = fmaxf(b2, __shfl_xor(b2, o2)); }
        __syncthreads();
        if (lane == 0 && wid < 2) { csS[wid] = a; csS[2 + wid] = b2; }
        __syncthreads();
        bqk = sqrtf(fmaxf(csS[0], csS[1])) * sqrtf(fmaxf(csS[2], csS[3])) * 1.01f;
    }
    const float thr = -(26.f + 2.f * bqk);
    const float c0 = cf[t0];
    int lo = 0, hi = 2 * qb;
    while (lo < hi) { const int mid = (lo + hi) >> 1; if (c0 - cf[mid * 64 + 63] >= thr) hi = mid; else lo = mid + 1; }
    int j_lo = lo; const int j_hi = 2 * qb + 1;
    float m = -1e30f, l = 0.f;
    f32x4 O[8];
#pragma unroll
    for (int d = 0; d < 8; ++d) O[d] = (f32x4){0.f, 0.f, 0.f, 0.f};
    u32x4 kreg[2], vreg[2]; float creg = 0.f;
#define ATT_LOAD(J) do { _Pragma("unroll") for (int u = 0; u < 2; ++u) { const int ci = tid + u * 512, key = ci >> 4, dc = ci & 15; const size_t go = (size_t)((J) * 64 + key) * 1024 + h * 128 + dc * 8; \
            kreg[u] = *(const u32x4*)(fk + go); vreg[u] = *(const u32x4*)(fv + go); } if (tid < 64) creg = cf[(J) * 64 + tid]; } while (0)
    ATT_LOAD(j_hi);
    for (int j = j_hi; j >= j_lo; --j) {
        __syncthreads();
#pragma unroll
        for (int u = 0; u < 2; ++u) {
            const int ci = tid + u * 512, key = ci >> 4, dc = ci & 15;
            *(u32x4*)(Ks + key * 136 + dc * 8) = kreg[u];
            const u32x4 vv = vreg[u];
            const int kpos = (((key >> 2) ^ dc) << 2) + (key & 3);
#pragma unroll
            for (int e = 0; e < 4; ++e) { vT[(dc * 8 + 2 * e) * 72 + kpos] = (bf16_t)(vv[e] & 0xffffu); vT[(dc * 8 + 2 * e + 1) * 72 + kpos] = (bf16_t)(vv[e] >> 16); }
        }
        if (tid < 64) csS[tid] = creg;
        __syncthreads();
        if (j > j_lo) ATT_LOAD(j - 1);
        if (j * 64 > tw + 15) continue;
        f32x4 S[4];
#pragma unroll
        for (int nt = 0; nt < 4; ++nt) { S[nt] = (f32x4){0.f, 0.f, 0.f, 0.f};
#pragma unroll
            for (int ks = 0; ks < 4; ++ks) S[nt] = mfma16(*(const bf16x8*)(Ks + (nt * 16 + r) * 136 + ks * 32 + q4 * 8), qf[ks], S[nt]); }
        float mx = -INFINITY;
#pragma unroll
        for (int nt = 0; nt < 4; ++nt)
#pragma unroll
            for (int jj = 0; jj < 4; ++jj) { const int key = nt * 16 + q4 * 4 + jj; float v = S[nt][jj] + ct - csS[key]; v = (j * 64 + key <= trow) ? v : -INFINITY; S[nt][jj] = v; mx = fmaxf(mx, v); }
        mx = fmaxf(mx, __shfl_xor(mx, 16)); mx = fmaxf(mx, __shfl_xor(mx, 32));
        const float mn = fmaxf(m, mx), alpha = __expf(m - mn); m = mn;
        float rs = 0.f;
#pragma unroll
        for (int nt = 0; nt < 4; ++nt)
#pragma unroll
            for (int jj = 0; jj < 4; ++jj) { const float pe = __expf(S[nt][jj] - mn); S[nt][jj] = pe; rs += pe; }
        rs += __shfl_xor(rs, 16); rs += __shfl_xor(rs, 32);
        l = l * alpha + rs;
#pragma unroll
        for (int d = 0; d < 8; ++d) { O[d][0] *= alpha; O[d][1] *= alpha; O[d][2] *= alpha; O[d][3] *= alpha; }
#pragma unroll
        for (int k2 = 0; k2 < 2; ++k2) {
            u32x4 pp; pp[0] = cvt_pk_bf16(S[2 * k2][0], S[2 * k2][1]); pp[1] = cvt_pk_bf16(S[2 * k2][2], S[2 * k2][3]); pp[2] = cvt_pk_bf16(S[2 * k2 + 1][0], S[2 * k2 + 1][1]); pp[3] = cvt_pk_bf16(S[2 * k2 + 1][2], S[2 * k2 + 1][3]);
            const bf16x8 pf = __builtin_bit_cast(bf16x8, pp);
#pragma unroll
            for (int d = 0; d < 8; ++d) {
                const int sw = (d * 2 + (r >> 3)) & 15;
                const u32x2 va = *(const u32x2*)(vT + (d * 16 + r) * 72 + ((((2 * k2) * 4 + q4) ^ sw) << 2)), vb = *(const u32x2*)(vT + (d * 16 + r) * 72 + ((((2 * k2 + 1) * 4 + q4) ^ sw) << 2));
                u32x4 vv; vv[0] = va[0]; vv[1] = va[1]; vv[2] = vb[0]; vv[3] = vb[1];
                O[d] = mfma16(__builtin_bit_cast(bf16x8, vv), pf, O[d]);
            }
        }
        if (j == j_hi - 1 && j > j_lo) {
            float mm = m;
#pragma unroll
            for (int o2 = 1; o2 < 16; o2 <<= 1) mm = fminf(mm, __shfl_xor(mm, o2));
            if (lane == 0) csS[64 + wid] = mm;
            __syncthreads();
            float mmin = csS[64];
#pragma unroll
            for (int w = 1; w < 8; ++w) mmin = fminf(mmin, csS[64 + w]);
            const float thr2 = -(26.f + fmaxf(bqk - mmin, 0.f));
            int lo2 = j_lo, hi2 = j;
            while (lo2 < hi2) { const int mid = (lo2 + hi2) >> 1; if (c0 - cf[mid * 64 + 63] >= thr2) hi2 = mid; else lo2 = mid + 1; }
            j_lo = lo2;
        }
    }
#undef ATT_LOAD
    const float il = 1.f / l;
#pragma unroll
    for (int d = 0; d < 8; ++d) { u32x2 o; o[0] = cvt_pk_bf16(O[d][0] * il, O[d][1] * il); o[1] = cvt_pk_bf16(O[d][2] * il, O[d][3] * il);
        *(u32x2*)(ya + (size_t)trow * 1024 + h * 128 + d * 16 + q4 * 4) = o; }
    __syncthreads();
}
__device__ void hg_scan_item(const Params& p, int item) {
    const int tid = threadIdx.x; unsigned char* ws = p.ws;
    const int h = item & 7, vg = item >> 3; const int v = vg * 4 + (tid >> 7), k = tid & 127;
    const bf16_t* LT = (const bf16_t*)(ws + OFF_LT); const float* dec = (const float*)(ws + OFF_DEC); bf16_t* ST = (bf16_t*)(ws + OFF_ST);
    float s = 0.f;
    bf16_t ltA[16], ltB[16]; float ddA[16], ddB[16];
#define SCAN_LOAD(LT_, DD_, C0) do { _Pragma("unroll") for (int u = 0; u < 16; ++u) { const int it = ((C0) + u) * 8 + h; LT_[u] = LT[(size_t)it * 16384 + v * 128 + k]; DD_[u] = dec[it * 128 + k]; } } while (0)
#define SCAN_STEP(LT_, DD_, C0) do { _Pragma("unroll") for (int u = 0; u < 16; ++u) { const int it = ((C0) + u) * 8 + h; ST[(size_t)it * 16384 + v * 128 + k] = f2bf(s); s = DD_[u] * s + bf2f(LT_[u]); } } while (0)
    SCAN_LOAD(ltA, ddA, 0);
#pragma unroll 1
    for (int c0 = 0; c0 < 128; c0 += 32) {
        __builtin_amdgcn_sched_barrier(0);
        SCAN_LOAD(ltB, ddB, c0 + 16);
        __builtin_amdgcn_sched_barrier(0);
        SCAN_STEP(ltA, ddA, c0);
        __builtin_amdgcn_sched_barrier(0);
        if (c0 + 32 < 128) SCAN_LOAD(ltA, ddA, c0 + 32);
        __builtin_amdgcn_sched_barrier(0);
        SCAN_STEP(ltB, ddB, c0 + 16);
    }
#undef SCAN_LOAD
#undef SCAN_STEP
}
__device__ void phase_attn_scan(const Params& p, unsigned char* smem) {
    for (int it = blockIdx.x; it < 256 + 512; it += gridDim.x) { if (it < 256) hg_scan_item(p, it); else attn_item(p, smem, it - 256); }
}
__device__ void phase_hg_out(const Params& p) {
    const int tid = threadIdx.x, wid = tid >> 6, lane = tid & 63, r = lane & 15, q4 = lane >> 4;
    unsigned char* ws = p.ws;
    const bf16_t* qe = (const bf16_t*)(ws + OFF_QE); const bf16_t* ST = (const bf16_t*)(ws + OFF_ST); const float* ointra = (const float*)(ws + OFF_OINTRA);
    const bf16_t* sgate = (const bf16_t*)(ws + OFF_SGATE); bf16_t* ob = (bf16_t*)(ws + OFF_OB);
    for (int wt = blockIdx.x * 8 + wid; wt < 4096; wt += gridDim.x * 8) {
        const int item = wt >> 2, tt = wt & 3, c = item >> 3, h = item & 7; const int t = c * 64 + tt * 16 + r;
        bf16x8 qf[4];
#pragma unroll
        for (int ks = 0; ks < 4; ++ks) qf[ks] = *(const bf16x8*)(qe + (size_t)t * 1024 + h * 128 + ks * 32 + q4 * 8);
        f32x4 o[8]; float ss = 0.f;
        bf16x8 sf[8][4];
#pragma unroll
        for (int vt = 0; vt < 8; ++vt) {
            o[vt] = *(const f32x4*)(ointra + (size_t)t * 1024 + h * 128 + vt * 16 + q4 * 4);
#pragma unroll
            for (int ks = 0; ks < 4; ++ks) sf[vt][ks] = *(const bf16x8*)(ST + (size_t)item * 16384 + (vt * 16 + r) * 128 + ks * 32 + q4 * 8);
        }
        __builtin_amdgcn_sched_barrier(0);
#pragma unroll
        for (int vt = 0; vt < 8; ++vt) {
            f32x4 acc = o[vt];
#pragma unroll
            for (int ks = 0; ks < 4; ++ks) acc = mfma16(sf[vt][ks], qf[ks], acc);
            o[vt] = acc; ss += acc[0] * acc[0] + acc[1] * acc[1] + acc[2] * acc[2] + acc[3] * acc[3];
        }
        ss += __shfl_xor(ss, 16); ss += __shfl_xor(ss, 32);
        const float rs = rsqrtf(ss * (1.f / 128.f) + EPS);
#pragma unroll
        for (int vt = 0; vt < 8; ++vt) {
            const int col = h * 128 + vt * 16 + q4 * 4; const f32x4 g = *(const f32x4*)(p.hg_norm_g + col); const u32x2 sg = *(const u32x2*)(sgate + (size_t)t * 1024 + col);
            u32x2 w; w[0] = cvt_pk_bf16(o[vt][0] * rs * g[0] * bflo(sg[0]), o[vt][1] * rs * g[1] * bfhi(sg[0])); w[1] = cvt_pk_bf16(o[vt][2] * rs * g[2] * bflo(sg[1]), o[vt][3] * rs * g[3] * bfhi(sg[1]));
            *(u32x2*)(ob + (size_t)t * 1024 + col) = w;
        }
    }
}
__device__ void phase_route(const Params& p, unsigned char* smem) {
    const int tid = threadIdx.x, wid = tid >> 6, lane = tid & 63, r = lane & 15, q4 = lane >> 4;
    unsigned char* ws = p.ws;
    const bf16_t* qp = (const bf16_t*)(ws + OFF_QP); const bf16_t* keys = (const bf16_t*)(ws + OFF_KEYS);
    int* idxo = (int*)(ws + OFF_IDX); float* gateo = (float*)(ws + OFF_GATE);
    float* sc = (float*)smem;
    float* top = sc + 128 * 129;
    float* part = top + 128 * 17;
    for (int item = blockIdx.x; item < 128 * 8; item += gridDim.x) {
        const int h = item & 7, t0 = (item >> 3) * 64;
        {
            const int c = wid >> 2, tt = wid & 3;
            bf16x8 af[4];
#pragma unroll
            for (int ks = 0; ks < 4; ++ks) af[ks] = *(const bf16x8*)(qp + (size_t)(t0 + tt * 16 + r) * 2048 + h * 256 + c * 128 + ks * 32 + q4 * 8);
            const bf16_t* kb = keys + (size_t)((h * 2 + c) * 128 + r) * 128 + q4 * 8;
#pragma unroll
            for (int half = 0; half < 2; ++half) {
                bf16x8 kf[4][4];
#pragma unroll
                for (int n2 = 0; n2 < 4; ++n2)
#pragma unroll
                    for (int ks = 0; ks < 4; ++ks) kf[n2][ks] = *(const bf16x8*)(kb + (size_t)((half * 4 + n2) * 16) * 128 + ks * 32);
                __builtin_amdgcn_sched_barrier(0);
#pragma unroll
                for (int n2 = 0; n2 < 4; ++n2) {
                    const int nt = half * 4 + n2; f32x4 acc = {0.f, 0.f, 0.f, 0.f};
#pragma unroll
                    for (int ks = 0; ks < 4; ++ks) acc = mfma16(af[ks], kf[n2][ks], acc);
#pragma unroll
                    for (int jj = 0; jj < 4; ++jj) sc[(c * 64 + tt * 16 + q4 * 4 + jj) * 129 + nt * 16 + r] = acc[jj];
                }
                __builtin_amdgcn_sched_barrier(0);
            }
        }
        __syncthreads();
        {
            const int row = tid & 127, qq = tid >> 7;
            float lst[16];
#pragma unroll
            for (int i = 0; i < 16; ++i) lst[i] = -INFINITY;
            const float* rowp = sc + row * 129 + qq * 32;
#pragma unroll 4
            for (int n = 0; n < 32; ++n) {
                float x = __uint_as_float((__float_as_uint(rowp[n]) & ~127u) | (unsigned)(qq * 32 + n));
#pragma unroll
                for (int i = 0; i < 16; ++i) { const float hi = fmaxf(lst[i], x); x = fminf(lst[i], x); lst[i] = hi; }
            }
#pragma unroll
            for (int i = 0; i < 16; ++i) part[(row * 4 + qq) * 16 + i] = lst[i];
        }
        __syncthreads();
        if (tid < 128) {
            const float* L = part + tid * 64; int p0 = 0, p1 = 0, p2 = 0, p3 = 0; float h0 = L[0], h1 = L[16], h2 = L[32], h3 = L[48];
#pragma unroll 1
            for (int k = 0; k < 16; ++k) {
                const float m = fmaxf(fmaxf(h0, h1), fmaxf(h2, h3)); top[tid * 17 + k] = m;
                if (m == h0) { ++p0; h0 = p0 < 16 ? L[p0] : -INFINITY; } else if (m == h1) { ++p1; h1 = p1 < 16 ? L[16 + p1] : -INFINITY; }
                else if (m == h2) { ++p2; h2 = p2 < 16 ? L[32 + p2] : -INFINITY; } else { ++p3; h3 = p3 < 16 ? L[48 + p3] : -INFINITY; }
            }
        }
        __syncthreads();
        if (tid < 64) {
            float a[16], bb[16], best[16];
#pragma unroll
            for (int i = 0; i < 16; ++i) { a[i] = top[tid * 17 + i]; bb[i] = top[(64 + tid) * 17 + i]; best[i] = -INFINITY; }
#pragma unroll
            for (int i = 0; i < 16; ++i)
#pragma unroll
                for (int j = 0; j < 16; ++j) if ((i + 1) * (j + 1) <= 16) {
                    float x = __uint_as_float((__float_as_uint(a[i] + bb[j]) & ~255u) | (unsigned)(i * 16 + j));
#pragma unroll
                    for (int k = 0; k < 16; ++k) { const float hi = fmaxf(best[k], x); x = fminf(best[k], x); best[k] = hi; }
                }
            float e[16], sum = 0.f;
#pragma unroll
            for (int k = 0; k < 16; ++k) { e[k] = __expf(best[k] - best[0]); sum += e[k]; }
            const float inv = 1.f / sum; const size_t ob = (size_t)(t0 + tid) * 128 + h * 16;
#pragma unroll
            for (int k = 0; k < 16; ++k) {
                const unsigned pos = __float_as_uint(best[k]) & 255u; const int i = pos >> 4, j = pos & 15;
                const int i0 = (int)(__float_as_uint(top[tid * 17 + i]) & 127u), i1 = (int)(__float_as_uint(top[(64 + tid) * 17 + j]) & 127u);
                idxo[ob + k] = i0 * 128 + i1; gateo[ob + k] = e[k] * inv;
            }
        }
        __syncthreads();
    }
}
__device__ void cvt_rows_fp8(const float* src, unsigned char* dst, float* scl, int wave, int nw) {
    const int lane = threadIdx.x & 63;
#pragma unroll 1
    for (int row0 = wave; row0 < 16384; row0 += nw * 2) {
        f32x4 v[2][8];
#pragma unroll
        for (int rr = 0; rr < 2; ++rr) { const int row = row0 + rr * nw; if (row < 16384) {
#pragma unroll
            for (int k = 0; k < 8; ++k) v[rr][k] = *(const f32x4*)(src + (size_t)row * 2048 + k * 256 + lane * 4); } }
#pragma unroll
        for (int rr = 0; rr < 2; ++rr) { const int row = row0 + rr * nw; if (row < 16384) {
            float mx = 0.f;
#pragma unroll
            for (int k = 0; k < 8; ++k) mx = fmaxf(mx, fmaxf(fmaxf(fabsf(v[rr][k][0]), fabsf(v[rr][k][1])), fmaxf(fabsf(v[rr][k][2]), fabsf(v[rr][k][3]))));
#pragma unroll
            for (int o = 32; o > 0; o >>= 1) mx = fmaxf(mx, __shfl_xor(mx, o));
            const float q = mx > 0.f ? 416.f / mx : 0.f;
#pragma unroll
            for (int k = 0; k < 8; ++k) { int w = 0; w = __builtin_amdgcn_cvt_pk_fp8_f32(v[rr][k][0] * q, v[rr][k][1] * q, w, false); w = __builtin_amdgcn_cvt_pk_fp8_f32(v[rr][k][2] * q, v[rr][k][3] * q, w, true);
                *(int*)(dst + (size_t)row * 2048 + k * 256 + lane * 4) = w; }
            if (lane == 0) scl[row] = mx * (1.f / 416.f);
        } }
    }
}
__device__ __forceinline__ float gelu_tanh(float x) { const float u = 0.7978845608028654f * (x + 0.044715f * x * x * x); const float t = 1.f - 2.f / (1.f + __expf(2.f * u)); return 0.5f * x * (1.f + t); }
__device__ void phase_peer(const Params& p) {
    const int tid = threadIdx.x, wid = tid >> 6, lane = tid & 63;
    unsigned char* ws = p.ws;
    const bf16_t* xg2 = (const bf16_t*)(ws + OFF_XG2); const float* sumsq = (const float*)(ws + OFF_SUMSQ);
    const int* idx = (const int*)(ws + OFF_IDX); const float* gate = (const float*)(ws + OFF_GATE);
    const unsigned char* U8 = ws + OFF_U8; const unsigned char* V8 = ws + OFF_V8; const float* usc = (const float*)(ws + OFF_USC); const float* vsc = (const float*)(ws + OFF_VSC);
    for (int t = blockIdx.x * 8 + wid; t < T; t += gridDim.x * 8) {
        const int tu = __builtin_amdgcn_readfirstlane(t);
        const float rs = row_rstd(sumsq, tu);
        float xv[32];
#pragma unroll
        for (int i = 0; i < 2; ++i)
#pragma unroll
            for (int hq = 0; hq < 2; ++hq) { const u32x4 a = *(const u32x4*)(xg2 + (size_t)tu * 2048 + i * 1024 + lane * 16 + hq * 8);
#pragma unroll
                for (int e = 0; e < 4; ++e) { xv[i * 16 + hq * 8 + 2 * e] = bflo(a[e]) * rs; xv[i * 16 + hq * 8 + 2 * e + 1] = bfhi(a[e]) * rs; } }
        const int e0 = idx[(size_t)tu * 128 + lane], e1 = idx[(size_t)tu * 128 + 64 + lane];
        const float us0 = usc[e0], us1 = usc[e1], vs0 = vsc[e0], vs1 = vsc[e1], g0 = gate[(size_t)tu * 128 + lane], g1 = gate[(size_t)tu * 128 + 64 + lane];
        float w0 = 0.f, w1 = 0.f;
        const bool b5 = (lane & 32) != 0, b4 = (lane & 16) != 0;
#define P10_ISSUE(BUF, TAB, B) do { _Pragma("unroll") for (int u = 0; u < 4; ++u) { const int e = __builtin_amdgcn_readlane((B) < 16 ? e0 : e1, (((B) & 15) << 2) + u); \
            const unsigned char* rp = (TAB) + (size_t)e * 2048 + lane * 16; BUF[u][0] = *(const u32x4*)rp; BUF[u][1] = *(const u32x4*)(rp + 1024); } } while (0)
#define P10_UDOT(BUF, B) do { float d[4]; _Pragma("unroll") for (int u = 0; u < 4; ++u) { float sacc = 0.f; _Pragma("unroll") for (int i = 0; i < 2; ++i) _Pragma("unroll") for (int q = 0; q < 4; ++q) { \
                const f32x2_t lo = __builtin_amdgcn_cvt_pk_f32_fp8((int)BUF[u][i][q], false), hi = __builtin_amdgcn_cvt_pk_f32_fp8((int)BUF[u][i][q], true); \
                sacc += lo[0] * xv[i * 16 + 4 * q] + lo[1] * xv[i * 16 + 4 * q + 1] + hi[0] * xv[i * 16 + 4 * q + 2] + hi[1] * xv[i * 16 + 4 * q + 3]; } d[u] = sacc; } \
            float r2[2]; _Pragma("unroll") for (int i = 0; i < 2; ++i) { const float mine = b5 ? d[2 + i] : d[i], oth = b5 ? d[i] : d[2 + i]; r2[i] = mine + __shfl_xor(oth, 32); } \
            float v1 = (b4 ? r2[1] : r2[0]) + __shfl_xor(b4 ? r2[0] : r2[1], 16); v1 += __shfl_xor(v1, 8); v1 += __shfl_xor(v1, 4); v1 += __shfl_xor(v1, 2); v1 += __shfl_xor(v1, 1); \
            const float mineT = __shfl(v1, (lane & 3) << 4);        \
            if ((lane >> 2) == ((B) & 15)) { if ((B) < 16) w0 = mineT; else w1 = mineT; } } while (0)
#define P10_VACC(BUF, B) do { _Pragma("unroll") for (int u = 0; u < 4; ++u) { const float w = __uint_as_float((unsigned)__builtin_amdgcn_readlane((int)__float_as_uint((B) < 16 ? w0 : w1), (((B) & 15) << 2) + u)); \
            _Pragma("unroll") for (int i = 0; i < 2; ++i) _Pragma("unroll") for (int q = 0; q < 4; ++q) { \
                const f32x2_t lo = __builtin_amdgcn_cvt_pk_f32_fp8((int)BUF[u][i][q], false), hi = __builtin_amdgcn_cvt_pk_f32_fp8((int)BUF[u][i][q], true); \
                acc[i * 16 + 4 * q] += w * lo[0]; acc[i * 16 + 4 * q + 1] += w * lo[1]; acc[i * 16 + 4 * q + 2] += w * hi[0]; acc[i * 16 + 4 * q + 3] += w * hi[1]; } } } while (0)
        u32x4 bufA[4][2], bufB[4][2];
        P10_ISSUE(bufA, U8, 0);
#pragma unroll 1
        for (int b2 = 0; b2 < 32; b2 += 2) {
            P10_ISSUE(bufB, U8, b2 + 1);
            P10_UDOT(bufA, b2);
            if (b2 + 2 < 32) P10_ISSUE(bufA, U8, b2 + 2); else P10_ISSUE(bufA, V8, 0);
            P10_UDOT(bufB, b2 + 1);
        }
        w0 = gelu_tanh(w0 * us0) * g0 * vs0; w1 = gelu_tanh(w1 * us1) * g1 * vs1;
        float acc[32];
#pragma unroll
        for (int i = 0; i < 32; ++i) acc[i] = 0.f;
#pragma unroll 1
        for (int b2 = 0; b2 < 32; b2 += 2) {
            P10_ISSUE(bufB, V8, b2 + 1);
            P10_VACC(bufA, b2);
            if (b2 + 2 < 32) P10_ISSUE(bufA, V8, b2 + 2);
            P10_VACC(bufB, b2 + 1);
        }
#undef P10_ISSUE
#undef P10_UDOT
#undef P10_VACC
        float* orow = p.out + (size_t)tu * 2048; float ss = 0.f;
#pragma unroll
        for (int i = 0; i < 2; ++i)
#pragma unroll
            for (int c = 0; c < 4; ++c) { const f32x4 a = *(const f32x4*)(orow + i * 1024 + lane * 16 + c * 4);
#pragma unroll
                for (int e = 0; e < 4; ++e) { acc[i * 16 + c * 4 + e] += a[e]; ss += acc[i * 16 + c * 4 + e] * acc[i * 16 + c * 4 + e]; } }
        ss = wave_sum(ss); const float rf = rsqrtf(ss * (1.f / 2048.f) + EPS);
#pragma unroll
        for (int i = 0; i < 2; ++i)
#pragma unroll
            for (int c = 0; c < 4; ++c) { const f32x4 g = *(const f32x4*)(p.norm_f_g + i * 1024 + lane * 16 + c * 4); f32x4 o;
#pragma unroll
                for (int e = 0; e < 4; ++e) o[e] = acc[i * 16 + c * 4 + e] * rf * g[e];
                *(f32x4*)(orow + i * 1024 + lane * 16 + c * 4) = o; }
    }
}

#ifndef DBG_STOP
#define DBG_STOP 0
#endif
__device__ void dbg_dump(const Params& p, const void* A, int a_f32, const void* B, int b_f32) {
    for (size_t i = (size_t)blockIdx.x * 512 + threadIdx.x; i < (size_t)T * 2048; i += (size_t)gridDim.x * 512) {
        const size_t t = i >> 11; const int c = (int)(i & 2047); const void* S = c < 1024 ? A : B; const int f = c < 1024 ? a_f32 : b_f32; const size_t o = t * 1024 + (c & 1023);
        p.out[i] = f ? ((const float*)S)[o] : bf2f(((const bf16_t*)S)[o]);
    }
}
__device__ __forceinline__ void fast_barrier(unsigned* bar, unsigned k) {
    asm volatile("s_waitcnt vmcnt(0)" ::: "memory");
    __syncthreads();
    if (threadIdx.x == 0) {
        __builtin_amdgcn_fence(__ATOMIC_RELEASE, "agent");
        asm volatile("s_waitcnt vmcnt(0)" ::: "memory");
        const unsigned g = blockIdx.x & 7u, ngr = gridDim.x < 8u ? gridDim.x : 8u, gsz = (gridDim.x - g + 7u) >> 3;
        const unsigned v = __hip_atomic_fetch_add(bar + 64u * g, 1u, __ATOMIC_RELAXED, __HIP_MEMORY_SCOPE_AGENT);
        if (v + 1u == gsz * k) {
            const unsigned t = __hip_atomic_fetch_add(bar + 64u * 8u, 1u, __ATOMIC_RELAXED, __HIP_MEMORY_SCOPE_AGENT);
            if (t + 1u == ngr * k) { for (unsigned j = 0; j < ngr; ++j) __hip_atomic_store(bar + 64u * (16u + j), k, __ATOMIC_RELAXED, __HIP_MEMORY_SCOPE_AGENT); }
        }
        while (__hip_atomic_load(bar + 64u * (16u + g), __ATOMIC_RELAXED, __HIP_MEMORY_SCOPE_AGENT) < k) __builtin_amdgcn_s_sleep(2);
        __builtin_amdgcn_fence(__ATOMIC_ACQUIRE, "agent");
        asm volatile("s_waitcnt vmcnt(0)" ::: "memory");
    }
    __syncthreads();
}
__global__ void __launch_bounds__(512, 2) fwd_megakernel(Params p) {
    extern __shared__ __attribute__((aligned(16))) unsigned char smem[];
    cg::grid_group grid = cg::this_grid();
#define GSYNC() do { asm volatile("s_waitcnt vmcnt(0)" ::: "memory"); grid.sync(); \
        if (threadIdx.x < 64) { __builtin_amdgcn_fence(__ATOMIC_ACQUIRE, "agent"); asm volatile("s_waitcnt vmcnt(0)" ::: "memory"); } __syncthreads(); } while (0)
    unsigned char* ws = p.ws;
    phase_prep(p, smem);
    if (p.ws == nullptr) GSYNC();
    fast_barrier((unsigned*)(ws + OFF_BAR), 1u);
    {
        FZ f; f.fq = (bf16_t*)(ws + OFF_FQ); f.fk = (bf16_t*)(ws + OFF_FK); f.fv = (bf16_t*)(ws + OFF_FV); f.qin = (bf16_t*)(ws + OFF_QIN); f.v = (bf16_t*)(ws + OFF_V);
        f.sgate = (bf16_t*)(ws + OFF_SGATE); f.sga = ws + OFF_SGA; f.sgb = ws + OFF_SGB; f.logfo = (float*)((unsigned char*)p.out + OUT_LOGF); f.lbl = p.hg_lb_logits;
        run_gemm(smem, (const bf16_t*)p.out, (const bf16_t*)(ws + OFF_WIN), T, NZ, 2048, f);
    }
    {
        const int nunits = (T / 256) * (NZ / 256), rem = nunits % (int)gridDim.x;
        const int first = rem ? rem : 0, nidle = (int)gridDim.x - first;
        if ((int)blockIdx.x >= first) { const int wv = ((int)blockIdx.x - first) * 8 + (int)(threadIdx.x >> 6);
            cvt_rows_fp8(p.peer_u, ws + OFF_U8, (float*)(ws + OFF_USC), wv, nidle * 8); cvt_rows_fp8(p.peer_v, ws + OFF_V8, (float*)(ws + OFF_VSC), wv, nidle * 8); }
    }
    fast_barrier((unsigned*)(ws + OFF_BAR), 2u);
    phase_hg_local(p, smem);
    fast_barrier((unsigned*)(ws + OFF_BAR), 3u);
    phase_attn_scan(p, smem);
    fast_barrier((unsigned*)(ws + OFF_BAR), 4u);
    if (DBG_STOP == 3) { dbg_dump(p, ws + OFF_YA, 0, ws + OFF_ST, 0); return; }
    phase_hg_out(p);
    fast_barrier((unsigned*)(ws + OFF_BAR), 5u);
    if (DBG_STOP == 4) { dbg_dump(p, ws + OFF_YA, 0, ws + OFF_OB, 0); return; }
    {
        FA fa; fa.merged = (bf16_t*)(ws + OFF_MERGED); fa.sg = ws + OFF_SGA;
        run_gemm(smem, (const bf16_t*)(ws + OFF_YA), (const bf16_t*)(ws + OFF_WA), T, 2048, 1024, fa);
        FB fb; fb.merged = (bf16_t*)(ws + OFF_MERGED); fb.sg = ws + OFF_SGB;
        run_gemm(smem, (const bf16_t*)(ws + OFF_OB), (const bf16_t*)(ws + OFF_WB), T, 2048, 1024, fb);
    }
    fast_barrier((unsigned*)(ws + OFF_BAR), 6u);
    {
        FO f; f.x = p.x; f.g2 = p.norm2_g; f.x1 = p.out; f.xg2 = (bf16_t*)(ws + OFF_XG2); f.sumsq = (float*)(ws + OFF_SUMSQ);
        run_gemm(smem, (const bf16_t*)(ws + OFF_MERGED), (const bf16_t*)(ws + OFF_WO), T, 2048, 2048, f);
    }
    fast_barrier((unsigned*)(ws + OFF_BAR), 7u);
    if (DBG_STOP == 6) { dbg_dump(p, ws + OFF_XG2, 0, ws + OFF_MERGED, 0); return; }
    {
        FQ f; f.qp = (bf16_t*)(ws + OFF_QP); f.sumsq = (const float*)(ws + OFF_SUMSQ);
        run_gemm(smem, (const bf16_t*)(ws + OFF_XG2), (const bf16_t*)(ws + OFF_WQ), T, 2048, 2048, f);
    }
    fast_barrier((unsigned*)(ws + OFF_BAR), 8u);
    if (DBG_STOP == 8) { dbg_dump(p, ws + OFF_QP, 0, ws + OFF_QP + 16 * MiB, 0); return; }
    phase_route(p, smem);
    fast_barrier((unsigned*)(ws + OFF_BAR), 9u);
    phase_peer(p);
}

extern "C" void kernel_launch(void* const* d_in, const int* in_sizes, int n_in, void* d_out, int out_size, void* d_ws, size_t ws_size, hipStream_t stream) {
    static int grid_blocks = 0;
    if (!grid_blocks) {
        int dev = 0, cus = 0, per_cu = 0;
        (void)hipGetDevice(&dev);
        (void)hipDeviceGetAttribute(&cus, hipDeviceAttributeMultiprocessorCount, dev);
        (void)hipFuncSetAttribute((const void*)fwd_megakernel, hipFuncAttributeMaxDynamicSharedMemorySize, LDS_BYTES);
        (void)hipOccupancyMaxActiveBlocksPerMultiprocessor(&per_cu, (const void*)fwd_megakernel, 512, LDS_BYTES);
        if (per_cu < 1) per_cu = 1;
        grid_blocks = cus * per_cu;
        if (ws_size < WS_END) fprintf(stderr, "kernel_launch: workspace too small (%zu < %zu)\n", ws_size, (size_t)WS_END);
    }
    Params p{};
    p.x = (const float*)d_in[0]; p.norm1_g = (const float*)d_in[1]; p.w_in = (const float*)d_in[2]; p.fox_f_bias = (const float*)d_in[3]; p.hg_lb_logits = (const float*)d_in[4];
    p.hg_norm_g = (const float*)d_in[5]; p.w_a_up = (const float*)d_in[6]; p.w_b_up = (const float*)d_in[7]; p.w_o = (const float*)d_in[8]; p.norm2_g = (const float*)d_in[9];
    p.peer_wq = (const float*)d_in[10]; p.peer_keys = (const float*)d_in[11]; p.peer_u = (const float*)d_in[12]; p.peer_v = (const float*)d_in[13]; p.norm_f_g = (const float*)d_in[14];
    p.out = (float*)d_out; p.ws = (unsigned char*)d_ws;
    (void)hipMemsetAsync((unsigned char*)d_ws + OFF_BAR, 0, BAR_BYTES, stream);
    void* args[] = {&p};
    hipError_t e = hipLaunchCooperativeKernel((const void*)fwd_megakernel, dim3(grid_blocks), dim3(512), args, LDS_BYTES, stream);
    if (e != hipSuccess) fprintf(stderr, "cooperative launch failed: %s (grid %d)\n", hipGetErrorString(e), grid_blocks);
}
```

```cpp
#include <hip/hip_runtime.h>
#include <hip/hip_cooperative_groups.h>
#include <cstdio>
namespace cg = cooperative_groups;
#define PG8_LAS __attribute__((address_space(3)))
typedef unsigned short bf16_t;
typedef short bf16x8 __attribute__((ext_vector_type(8)));
typedef float f32x4 __attribute__((ext_vector_type(4)));
typedef unsigned u32x4 __attribute__((ext_vector_type(4)));
constexpr int BM = 256, BK = 64, HALF = 128, HTB = HALF * BK * 2  , STAGE_BYTES = 8 * HTB, NXCD = 8, WGM = 8;

__host__ __device__ __forceinline__ int lds_byte(int r, int c) { const int st = (r >> 4) * 2 + (c >> 5), rr = r & 15, cc = c & 31, ob = rr * 64 + cc * 2; return st * 1024 + (ob ^ (((ob >> 9) & 1) << 5)); }
__host__ __device__ __forceinline__ void stage_rc(int b, int& R, int& C) { const int st = b / 1024, sb = b % 1024, swz = sb ^ (((sb >> 9) & 1) << 5); R = (st >> 1) * 16 + swz / 64; C = (st & 1) * 32 + (swz % 64) / 2; }
__host__ __device__ __forceinline__ int perm32(int rho) { const int n = rho >> 4, i = rho & 15; return 8 * (i >> 2) + 4 * n + (i & 3); }

struct Unit { int pm, pn; };
struct Gemm { const bf16_t* A; const bf16_t* Bt; int M, N, K; };

struct StaticOrder {
    int nM, nN, nwg, G, c;
    __host__ __device__ void init(int M, int N, int G_, int c_) { nM = M / BM; nN = N / BM; nwg = nM * nN; G = G_; c = c_; }
    __host__ __device__ bool next(int i, Unit& u) const {
        const long L = (long)i * G + c; if (L >= nwg) return false;
        int wgid = (int)L; { const int q = nwg / NXCD, r = nwg % NXCD, xcd = wgid % NXCD, off = wgid / NXCD; wgid = (xcd < r ? xcd * (q + 1) : r * (q + 1) + (xcd - r) * q) + off; }
        const int nig = WGM * nN, gid = wgid / nig, fm = gid * WGM, gsz = (nM - fm) < WGM ? (nM - fm) : WGM;
        u.pm = fm + ((wgid % nig) % gsz); u.pn = (wgid % nig) / gsz; return true;
    }
    __device__ __forceinline__ void a_ready(const Unit&) const {}
    __device__ __forceinline__ void done(const Unit&) const {}
};
typedef __bf16 bf16x2_t __attribute__((ext_vector_type(2)));
typedef float f32x2_t __attribute__((ext_vector_type(2)));
__device__ __forceinline__ unsigned cvt_pk_bf16(float lo, float hi) { f32x2_t v = {lo, hi}; bf16x2_t r = __builtin_convertvector(v, bf16x2_t); return __builtin_bit_cast(unsigned, r); }
template <class Epi, class Sched>
__device__ __forceinline__ void gemm_phase(PG8_LAS unsigned char* lds, const Gemm g, const Sched& S, const Epi& E) {
    const int tid = threadIdx.x, wid = __builtin_amdgcn_readfirstlane(tid >> 6), lane = tid & 63, wr = wid >> 2, wc = wid & 3, fr = lane & 15, fq = lane >> 4;
    const int K = g.K, nt = K / BK;
    unsigned voffA[2], voffB[2];
#pragma unroll
    for (int i = 0; i < 2; ++i) { int R, C; stage_rc(tid * 16 + i * 8192, R, C); const int Rb = Epi::PERM ? ((R & ~31) + perm32(R & 31)) : R;
        voffA[i] = (unsigned)(R * K + C) * 2u; voffB[i] = (unsigned)(Rb * K + C) * 2u; }
    const size_t kstep = (size_t)(BK * 2);
    const size_t hstep = (size_t)HALF * K * 2;
    const size_t tstep = 2 * hstep;
    const unsigned ldsw = (unsigned)wid * 1024u;
    const int aoff = lds_byte(wr * 64 + fr, fq * 8), boff = lds_byte(wc * 32 + fr, fq * 8);
#define PG8_SA(b, h) (((b) * 2 + (h)) * HTB)
#define PG8_SB(b, h) ((4 + (b) * 2 + (h)) * HTB)
#define PG8_STAGE(bufoff, gbase, voff) do { _Pragma("unroll") for (int _i = 0; _i < 2; ++_i) \
        __builtin_amdgcn_global_load_lds((const unsigned*)((const char*)(gbase) + (voff)[_i]), (PG8_LAS unsigned*)(lds + (bufoff) + ldsw + _i * 8192), 16, 0, 0); } while (0)
#define PG8_LDA(dst, b, h) do { _Pragma("unroll") for (int m = 0; m < 4; ++m) _Pragma("unroll") for (int k = 0; k < 2; ++k) dst[m][k] = *(const PG8_LAS bf16x8*)(lds + PG8_SA(b, h) + aoff + m * 2048 + k * 1024); } while (0)
#define PG8_LDB(dst, b, h) do { _Pragma("unroll") for (int n = 0; n < 2; ++n) _Pragma("unroll") for (int k = 0; k < 2; ++k) dst[n][k] = *(const PG8_LAS bf16x8*)(lds + PG8_SB(b, h) + boff + n * 2048 + k * 1024); } while (0)
#define PG8_MMA(ai, bj, At, Bt) do { __builtin_amdgcn_s_setprio(1); _Pragma("unroll") for (int m = 0; m < 4; ++m) _Pragma("unroll") for (int n = 0; n < 2; ++n) _Pragma("unroll") for (int k = 0; k < 2; ++k) \
        acc[ai][bj][m][n] = __builtin_amdgcn_mfma_f32_16x16x32_bf16(Bt[n][k], At[m][k], acc[ai][bj][m][n], 0, 0, 0); __builtin_amdgcn_s_setprio(0); } while (0)
#define PG8_WAIT_V(n) asm volatile("s_waitcnt vmcnt(" #n ")" ::: "memory")
#define PG8_WAIT_L(n) asm volatile("s_waitcnt lgkmcnt(" #n ")" ::: "memory")
#define PG8_BAR __builtin_amdgcn_s_barrier()
#define PG8_SCHED __builtin_amdgcn_sched_barrier(0)
    Unit cur, nxt; int ui = 0;
    if (!S.next(0, cur)) return;
    f32x4 acc[2][2][4][2];
#pragma unroll
    for (int a = 0; a < 2; ++a)
#pragma unroll
        for (int b = 0; b < 2; ++b)
#pragma unroll
            for (int m = 0; m < 4; ++m)
#pragma unroll
                for (int n = 0; n < 2; ++n) acc[a][b][m][n] = (f32x4){0.f, 0.f, 0.f, 0.f};
    bf16x8 At[4][2], B0[2][2], B1[2][2];
    const char* cA = (const char*)g.A + (size_t)cur.pm * tstep; const char* cB = (const char*)g.Bt + (size_t)cur.pn * tstep;
    S.a_ready(cur);
    PG8_STAGE(PG8_SB(0, 0), cB, voffB); PG8_STAGE(PG8_SA(0, 0), cA, voffA); PG8_STAGE(PG8_SB(0, 1), cB + hstep, voffB); PG8_STAGE(PG8_SA(0, 1), cA + hstep, voffA);
    if (wr == 1) PG8_BAR;
    PG8_WAIT_V(4); PG8_BAR;
    PG8_STAGE(PG8_SB(1, 0), cB + kstep, voffB); PG8_STAGE(PG8_SA(1, 0), cA + kstep, voffA); PG8_STAGE(PG8_SB(1, 1), cB + hstep + kstep, voffB);
    PG8_WAIT_V(6); PG8_BAR;
    for (;;) {
        const bool has_next = S.next(ui + 1, nxt);
        const char* nA = has_next ? (const char*)g.A + (size_t)nxt.pm * tstep : cA; const char* nB = has_next ? (const char*)g.Bt + (size_t)nxt.pn * tstep : cB;
        for (int t = 0; t < nt; t += 2) {
            const bool last = (t == nt - 2);
            const char* a1 = cA + (size_t)(t + 1) * kstep;
            const char* a2 = last ? nA : cA + (size_t)(t + 2) * kstep; const char* b2 = last ? nB : cB + (size_t)(t + 2) * kstep;
            const char* a3 = a2 + kstep; const char* b3 = b2 + kstep;
            if (last && has_next) S.a_ready(nxt);
            PG8_LDB(B0, 0, 0); PG8_SCHED; PG8_LDA(At, 0, 0); PG8_STAGE(PG8_SA(1, 1), a1 + hstep, voffA);
            PG8_WAIT_L(8); PG8_BAR; PG8_WAIT_L(0); PG8_MMA(0, 0, At, B0); PG8_BAR; PG8_SCHED;
            PG8_LDB(B1, 0, 1); PG8_STAGE(PG8_SB(0, 0), b2, voffB);
            PG8_BAR; PG8_WAIT_L(0); PG8_MMA(0, 1, At, B1); PG8_BAR;
            PG8_LDA(At, 0, 1); PG8_STAGE(PG8_SA(0, 0), a2, voffA);
            PG8_BAR; PG8_WAIT_L(0); PG8_MMA(1, 0, At, B0); PG8_BAR; PG8_SCHED;
            PG8_STAGE(PG8_SB(0, 1), b2 + hstep, voffB);
            PG8_WAIT_V(6); PG8_BAR; PG8_MMA(1, 1, At, B1); PG8_BAR;
            PG8_LDB(B0, 1, 0); PG8_SCHED; PG8_LDA(At, 1, 0); PG8_STAGE(PG8_SA(0, 1), a2 + hstep, voffA);
            PG8_WAIT_L(8); PG8_BAR; PG8_WAIT_L(0); PG8_MMA(0, 0, At, B0); PG8_BAR; PG8_SCHED;
            PG8_LDB(B1, 1, 1); PG8_STAGE(PG8_SB(1, 0), b3, voffB);
            PG8_BAR; PG8_WAIT_L(0); PG8_MMA(0, 1, At, B1); PG8_BAR;
            PG8_LDA(At, 1, 1); PG8_STAGE(PG8_SA(1, 0), a3, voffA);
            PG8_BAR; PG8_WAIT_L(0); PG8_MMA(1, 0, At, B0); PG8_BAR; PG8_SCHED;
            PG8_STAGE(PG8_SB(1, 1), b3 + hstep, voffB);
            PG8_WAIT_V(6); PG8_BAR; PG8_MMA(1, 1, At, B1); PG8_BAR;
        }
        if constexpr (!Epi::AFTER_DRAIN) { E(acc, cur, wr, wc, fr, fq); S.done(cur); }
        if (!has_next) break;
#pragma unroll
        for (int a = 0; a < 2; ++a)
#pragma unroll
            for (int b = 0; b < 2; ++b)
#pragma unroll
                for (int m = 0; m < 4; ++m)
#pragma unroll
                    for (int n = 0; n < 2; ++n) acc[a][b][m][n] = (f32x4){0.f, 0.f, 0.f, 0.f};
        cur = nxt; cA = nA; cB = nB; ++ui;
    }
    PG8_WAIT_V(0);
    if (wr == 0) PG8_BAR;
    PG8_BAR;
    if constexpr (Epi::AFTER_DRAIN) { E.fused(acc, cur, wr, wc, fr, fq, lds, wid, lane); S.done(cur); }
#undef PG8_SA
#undef PG8_SB
#undef PG8_STAGE
#undef PG8_LDA
#undef PG8_LDB
#undef PG8_MMA
#undef PG8_WAIT_V
#undef PG8_WAIT_L
#undef PG8_BAR
#undef PG8_SCHED
}
#define LAS PG8_LAS
typedef unsigned u32x2 __attribute__((ext_vector_type(2)));
typedef float f32x2 __attribute__((ext_vector_type(2)));

constexpr int T = 8192, D = 2048, NZ = 11264, NIN_SRC = 11272;
constexpr float EPS = 1e-6f;
constexpr size_t MiB = 1ull << 20;
constexpr size_t OFF_WIN = 0;
constexpr size_t OFF_QIN = 44 * MiB;
constexpr size_t OFF_V = 60 * MiB;
constexpr size_t OFF_FQ = 76 * MiB, OFF_FK = 92 * MiB, OFF_FV = 108 * MiB;
constexpr size_t OFF_LT = 124 * MiB;
constexpr size_t OFF_WA = 156 * MiB;
constexpr size_t OFF_WB = 160 * MiB;
constexpr size_t OFF_WO = 164 * MiB;
constexpr size_t OFF_WQ = 172 * MiB;
constexpr size_t OFF_KEYS = 180 * MiB;
constexpr size_t OFF_LOGFA = 180 * MiB + 512 * 1024;
constexpr size_t OFF_CFOX = OFF_LOGFA + 256 * 1024;
constexpr size_t OFF_BQ = OFF_CFOX + 256 * 1024;
constexpr size_t OFF_DEC = OFF_BQ + 1024;
constexpr size_t OFF_USC = 181 * MiB + 768 * 1024;
constexpr size_t OFF_VSC = 181 * MiB + 832 * 1024;
constexpr size_t OFF_BAR = 181 * MiB + 896 * 1024;
constexpr size_t BAR_BYTES = 8192;
constexpr size_t OFF_NM = 181 * MiB + 904 * 1024;
constexpr size_t OFF_SUMSQ = 182 * MiB;
constexpr size_t OFF_SGATE = 183 * MiB;
constexpr size_t OFF_SGA = 199 * MiB;
constexpr size_t OFF_SGB = 215 * MiB;
constexpr size_t OFF_V8 = 231 * MiB;
constexpr size_t OFF_ST = 263 * MiB;
constexpr size_t OFF_OINTRA = 295 * MiB;
constexpr size_t OFF_QE = 327 * MiB;
constexpr size_t OFF_YA = 343 * MiB;
constexpr size_t OFF_OB = 359 * MiB;
constexpr size_t OFF_MERGED = 375 * MiB;
constexpr size_t OFF_XG2 = 407 * MiB;
constexpr size_t OFF_QP = 439 * MiB;
constexpr size_t OFF_IDX = 471 * MiB;
constexpr size_t OFF_GATE = 475 * MiB;
constexpr size_t OFF_U8 = 479 * MiB;
constexpr size_t WS_END = 511 * MiB;
constexpr size_t OUT_LOGF = 32 * MiB;
constexpr int LDS_BYTES = 131072;

struct Params {
    const float *x, *norm1_g, *w_in, *fox_f_bias, *hg_lb_logits, *hg_norm_g, *w_a_up, *w_b_up, *w_o, *norm2_g, *peer_wq, *peer_keys, *peer_u, *peer_v, *norm_f_g;
    float* out; unsigned char* ws;
};

__device__ __forceinline__ float bf2f(bf16_t b) { return __uint_as_float(((unsigned)b) << 16); }
__device__ __forceinline__ float bflo(unsigned u) { return __uint_as_float(u << 16); }
__device__ __forceinline__ float bfhi(unsigned u) { return __uint_as_float(u & 0xffff0000u); }
__device__ __forceinline__ bf16_t f2bf(float f) { return (bf16_t)(cvt_pk_bf16(f, 0.f) & 0xffffu); }
__device__ __forceinline__ float wave_sum(float v) {
#pragma unroll
    for (int o = 32; o > 0; o >>= 1) v += __shfl_xor(v, o);
    return v;
}
__device__ __forceinline__ float sigmoidf_(float x) { return 1.f / (1.f + __expf(-x)); }
__device__ __forceinline__ float siluf_(float x) { return x / (1.f + __expf(-x)); }
__device__ __forceinline__ f32x4 mfma16(bf16x8 a, bf16x8 b, f32x4 c) { return __builtin_amdgcn_mfma_f32_16x16x32_bf16(a, b, c, 0, 0, 0); }
__device__ __forceinline__ unsigned cvt_pk_bf16_asm(float lo, float hi) { unsigned r; asm volatile("v_cvt_pk_bf16_f32 %0, %1, %2" : "=v"(r) : "v"(lo), "v"(hi)); return r; }
__device__ __forceinline__ u32x4 pack8(const float* v) { u32x4 o; o[0] = cvt_pk_bf16_asm(v[0], v[1]); o[1] = cvt_pk_bf16_asm(v[2], v[3]); o[2] = cvt_pk_bf16_asm(v[4], v[5]); o[3] = cvt_pk_bf16_asm(v[6], v[7]); return o; }

__device__ __forceinline__ float row_rstd(const float* ssp, int row) {
    const f32x4* q = (const f32x4*)(ssp + (size_t)row * 32); float s = 0.f;
#pragma unroll
    for (int i = 0; i < 8; ++i) { const f32x4 v = q[i]; s += (v[0] + v[1]) + (v[2] + v[3]); }
    return rsqrtf(s * (1.f / 2048.f) + EPS);
}
template <class F> struct EpiRow {
    static constexpr bool PERM = true, AFTER_DRAIN = false;
    F f;
    __device__ __forceinline__ void operator()(const f32x4 (&acc)[2][2][4][2], const Unit& u, int wr, int wc, int fr, int fq) const {
        const int row0 = u.pm * BM + wr * 64 + fr, col0 = u.pn * BM + wc * 32 + 8 * fq;
        asm volatile("s_nop 15\n\ts_nop 15" ::: "memory");
#pragma unroll
        for (int ai = 0; ai < 2; ++ai)
#pragma unroll
            for (int m = 0; m < 4; ++m) {
                const int row = row0 + ai * HALF + m * 16;
                float v[2][8];
#pragma unroll
                for (int bj = 0; bj < 2; ++bj)
#pragma unroll
                    for (int e = 0; e < 4; ++e) { v[bj][e] = acc[ai][bj][m][0][e]; v[bj][4 + e] = acc[ai][bj][m][1][e]; }
                f(row, col0, v[0], col0 + HALF, v[1], u);
            }
    }
};
__device__ __forceinline__ void st8bf(bf16_t* p, const float* v) { *(u32x4*)p = pack8(v); }

struct FZ {
    bf16_t *fq, *fk, *fv, *qin, *v, *sgate; unsigned char *sga, *sgb; float* logfo; const float* lbl;
    __device__ __forceinline__ void one(int row, int c, const float* a) const {
        const int reg = c >> 10, lc = c & 1023; float o[8];
        const size_t r1 = (size_t)row * 1024 + lc;
        if (reg == 0) {
#pragma unroll
            for (int e = 0; e < 8; ++e) o[e] = a[e] * 0.08838834764831845f;
            st8bf(fq + r1, o);
        } else if (reg == 1) { st8bf(fk + r1, a);
        } else if (reg == 2) { st8bf(fv + r1, a);
        } else if (reg == 3) {
#pragma unroll
            for (int e = 0; e < 8; ++e) o[e] = siluf_(a[e]);
            st8bf(qin + r1, o);
        } else if (reg == 4) {
            const f32x4 l0a = *(const f32x4*)(lbl + lc), l0b = *(const f32x4*)(lbl + lc + 4), l1a = *(const f32x4*)(lbl + 1024 + lc), l1b = *(const f32x4*)(lbl + 1024 + lc + 4);
#pragma unroll
            for (int e = 0; e < 8; ++e) { const float l0 = e < 4 ? l0a[e & 3] : l0b[e & 3], l1 = e < 4 ? l1a[e & 3] : l1b[e & 3];
                const float lb = 1.f / (1.f + __expf(l1 - l0)); const float f = lb + (1.f - lb) * sigmoidf_(a[e]); o[e] = logf(f); }
            *(f32x4*)(logfo + r1) = (f32x4){o[0], o[1], o[2], o[3]}; *(f32x4*)(logfo + r1 + 4) = (f32x4){o[4], o[5], o[6], o[7]};
        } else if (reg == 5) { st8bf(v + r1, a);
        } else if (reg == 6) {
#pragma unroll
            for (int e = 0; e < 8; ++e) o[e] = siluf_(a[e]);
            st8bf(sgate + r1, o);
        } else {
#pragma unroll
            for (int e = 0; e < 8; ++e) o[e] = sigmoidf_(a[e]);
            u32x2 pk; pk[0] = (unsigned)(o[0] * 255.f + 0.5f) | ((unsigned)(o[1] * 255.f + 0.5f) << 8) | ((unsigned)(o[2] * 255.f + 0.5f) << 16) | ((unsigned)(o[3] * 255.f + 0.5f) << 24);
            pk[1] = (unsigned)(o[4] * 255.f + 0.5f) | ((unsigned)(o[5] * 255.f + 0.5f) << 8) | ((unsigned)(o[6] * 255.f + 0.5f) << 16) | ((unsigned)(o[7] * 255.f + 0.5f) << 24);
            if (reg < 9) *(u32x2*)(sga + (size_t)row * 2048 + (c - 7168)) = pk; else *(u32x2*)(sgb + (size_t)row * 2048 + (c - 9216)) = pk;
        }
    }
    __device__ __forceinline__ void operator()(int row, int cA, const float* vA, int cB, const float* vB, const Unit&) const { one(row, cA, vA); one(row, cB, vB); }
};
struct FA {
    bf16_t* merged; const unsigned char* sg;
    __device__ __forceinline__ void one(int row, int c, const float* a) const {
        const size_t o = (size_t)row * 2048 + c; const u32x2 g = *(const u32x2*)(sg + o); float r[8];
#pragma unroll
        for (int e = 0; e < 8; ++e) r[e] = a[e] * ((float)((g[e >> 2] >> (8 * (e & 3))) & 255u) * (1.f / 255.f));
        st8bf(merged + o, r);
    }
    __device__ __forceinline__ void operator()(int row, int cA, const float* vA, int cB, const float* vB, const Unit&) const { one(row, cA, vA); one(row, cB, vB); }
};
struct FB {
    bf16_t* merged; const unsigned char* sg;
    __device__ __forceinline__ void one(int row, int c, const float* a) const {
        const size_t o = (size_t)row * 2048 + c; const u32x2 g = *(const u32x2*)(sg + o); const u32x4 mm = *(const u32x4*)(merged + o); float r[8];
#pragma unroll
        for (int e = 0; e < 8; ++e) r[e] = ((e & 1) ? bfhi(mm[e >> 1]) : bflo(mm[e >> 1])) + a[e] * ((float)((g[e >> 2] >> (8 * (e & 3))) & 255u) * (1.f / 255.f));
        st8bf(merged + o, r);
    }
    __device__ __forceinline__ void operator()(int row, int cA, const float* vA, int cB, const float* vB, const Unit&) const { one(row, cA, vA); one(row, cB, vB); }
};
struct FO {
    const float* x; const float* g2; float* x1; bf16_t* xg2; float* sumsq;
    __device__ __forceinline__ float one(int row, int c, const float* a) const {
        const size_t o = (size_t)row * 2048 + c; const f32x4 xa = *(const f32x4*)(x + o), xb = *(const f32x4*)(x + o + 4), ga = *(const f32x4*)(g2 + c), gb = *(const f32x4*)(g2 + c + 4);
        float r[8], s = 0.f, w[8];
#pragma unroll
        for (int e = 0; e < 8; ++e) { r[e] = a[e] + (e < 4 ? xa[e & 3] : xb[e & 3]); s += r[e] * r[e]; w[e] = r[e] * (e < 4 ? ga[e & 3] : gb[e & 3]); }
        *(f32x4*)(x1 + o) = (f32x4){r[0], r[1], r[2], r[3]}; *(f32x4*)(x1 + o + 4) = (f32x4){r[4], r[5], r[6], r[7]};
        st8bf(xg2 + o, w); return s;
    }
    __device__ __forceinline__ void operator()(int row, int cA, const float* vA, int cB, const float* vB, const Unit& u) const {
        float s = one(row, cA, vA) + one(row, cB, vB);
        s += __shfl_xor(s, 16); s += __shfl_xor(s, 32);
        if ((threadIdx.x & 63) < 16) sumsq[(size_t)row * 32 + u.pn * 4 + ((threadIdx.x >> 6) & 3)] = s;
    }
};
struct FQ {
    bf16_t* qp; const float* sumsq;
    __device__ __forceinline__ void operator()(int row, int cA, const float* vA, int cB, const float* vB, const Unit&) const {
        const float rs = row_rstd(sumsq, row); float r[8];
#pragma unroll
        for (int e = 0; e < 8; ++e) r[e] = vA[e] * rs;
        st8bf(qp + (size_t)row * 2048 + cA, r);
#pragma unroll
        for (int e = 0; e < 8; ++e) r[e] = vB[e] * rs;
        st8bf(qp + (size_t)row * 2048 + cB, r);
    }
};
template <class F> __device__ __forceinline__ void run_gemm(unsigned char* smem, const bf16_t* A, const bf16_t* Bt, int M, int N, int K, const F& f) {
    Gemm g; g.A = A; g.Bt = Bt; g.M = M; g.N = N; g.K = K;
    StaticOrder S; S.init(M, N, (int)gridDim.x, (int)blockIdx.x);
    EpiRow<F> E{f};
    gemm_phase<EpiRow<F>, StaticOrder>((LAS unsigned char*)smem, g, S, E);
    __syncthreads();
}
__device__ __forceinline__ void transpose_tile(const float* src, int ldsrc, int srccol0, bf16_t* dst, int K, int k0, int n0, float* tl) {
    const int tid = threadIdx.x, j4 = tid & 31, i = tid >> 5;
    f32x4 v[4];
#pragma unroll
    for (int r = 0; r < 4; ++r) v[r] = *(const f32x4*)(src + (size_t)(k0 + r * 16 + i) * ldsrc + srccol0 + j4 * 4);
#pragma unroll
    for (int r = 0; r < 4; ++r) { const int k = r * 16 + i;
#pragma unroll
        for (int e = 0; e < 4; ++e) tl[(j4 * 4 + e) * 65 + (k ^ (j4 >> 3))] = v[r][e]; }
    __syncthreads();
    const int n = tid >> 2, kc = tid & 3; float o[16];
#pragma unroll
    for (int e = 0; e < 16; ++e) o[e] = tl[n * 65 + ((kc * 16 + e) ^ (n >> 5))];
    st8bf(dst + (size_t)(n0 + n) * K + k0 + kc * 16, o); st8bf(dst + (size_t)(n0 + n) * K + k0 + kc * 16 + 8, o + 8);
    __syncthreads();
}
__device__ __forceinline__ void cvt_stream(const float* src, bf16_t* dst, size_t n) {
    const size_t nthr = (size_t)gridDim.x * 512, gt = (size_t)blockIdx.x * 512 + threadIdx.x;
    for (size_t i = gt * 8; i < n; i += nthr * 8) {
        const f32x4 a = *(const f32x4*)(src + i), b = *(const f32x4*)(src + i + 4);
        float v[8] = {a[0], a[1], a[2], a[3], b[0], b[1], b[2], b[3]};
        st8bf(dst + i, v);
    }
}
__device__ void phase_prep(const Params& p, unsigned char* smem) {
    const int tid = threadIdx.x, wid = tid >> 6, lane = tid & 63, nb = gridDim.x, b = blockIdx.x;
    unsigned char* ws = p.ws;
    float* tl = (float*)smem;
    float* wff = (float*)(smem + 36864);
    {
        for (int it = b; it < 32 * 88; it += nb) { const int kt = it / 88, nt = it % 88; const int n0 = nt * 128; transpose_tile(p.w_in, NIN_SRC, n0 < 3072 ? n0 : n0 + 8, (bf16_t*)(ws + OFF_WIN), 2048, kt * 64, n0, tl); }
        for (int it = b; it < 16 * 16; it += nb) { const int kt = it / 16, nt = it % 16; transpose_tile(p.w_a_up, 2048, nt * 128, (bf16_t*)(ws + OFF_WA), 1024, kt * 64, nt * 128, tl); }
        for (int it = b; it < 16 * 16; it += nb) { const int kt = it / 16, nt = it % 16; transpose_tile(p.w_b_up, 2048, nt * 128, (bf16_t*)(ws + OFF_WB), 1024, kt * 64, nt * 128, tl); }
        for (int it = b; it < 32 * 16; it += nb) { const int kt = it / 16, nt = it % 16; transpose_tile(p.w_o, 2048, nt * 128, (bf16_t*)(ws + OFF_WO), 2048, kt * 64, nt * 128, tl); }
        for (int it = b; it < 32 * 16; it += nb) { const int kt = it / 16, nt = it % 16; transpose_tile(p.peer_wq, 2048, nt * 128, (bf16_t*)(ws + OFF_WQ), 2048, kt * 64, nt * 128, tl); }
    }
    {
        f32x4 wa[4], wb[4];
#pragma unroll
        for (int u = 0; u < 4; ++u) { const float* src = p.w_in + (size_t)(tid + u * 512) * NIN_SRC + 3072; wa[u] = *(const f32x4*)src; wb[u] = *(const f32x4*)(src + 4); }
#pragma unroll
        for (int u = 0; u < 4; ++u) { const int d = tid + u * 512;
#pragma unroll
            for (int hh = 0; hh < 4; ++hh) { wff[hh * 2048 + d] = wa[u][hh]; wff[(4 + hh) * 2048 + d] = wb[u][hh]; } }
    }
    __syncthreads();
    {
        bf16_t* h = (bf16_t*)p.out; float* logfa = (float*)(ws + OFF_LOGFA);
        const bool b5 = (lane & 32) != 0, b4 = (lane & 16) != 0, b3 = (lane & 8) != 0;
        f32x4 xn[8];
        { const int row = b * 8 + wid; if (row < T) {
#pragma unroll
            for (int i = 0; i < 8; ++i) xn[i] = *(const f32x4*)(p.x + (size_t)row * D + i * 256 + lane * 4); } }
#pragma unroll 1
        for (int row = b * 8 + wid; row < T; row += nb * 8) {
            f32x4 xv[8]; float ss = 0.f;
#pragma unroll
            for (int i = 0; i < 8; ++i) { xv[i] = xn[i]; ss += xv[i][0] * xv[i][0] + xv[i][1] * xv[i][1] + xv[i][2] * xv[i][2] + xv[i][3] * xv[i][3]; }
            { const int rown = row + nb * 8; if (rown < T) {
#pragma unroll
                for (int i = 0; i < 8; ++i) xn[i] = *(const f32x4*)(p.x + (size_t)rown * D + i * 256 + lane * 4); } }
            ss = wave_sum(ss); const float rs = rsqrtf(ss * (1.f / 2048.f) + EPS);
            float fa[8] = {0, 0, 0, 0, 0, 0, 0, 0};
#pragma unroll
            for (int i = 0; i < 8; ++i) {
                const f32x4 g = *(const f32x4*)(p.norm1_g + i * 256 + lane * 4);
                f32x4 hv; hv[0] = xv[i][0] * rs * g[0]; hv[1] = xv[i][1] * rs * g[1]; hv[2] = xv[i][2] * rs * g[2]; hv[3] = xv[i][3] * rs * g[3];
                u32x2 o; o[0] = cvt_pk_bf16_asm(hv[0], hv[1]); o[1] = cvt_pk_bf16_asm(hv[2], hv[3]);
                *(u32x2*)(h + (size_t)row * D + i * 256 + lane * 4) = o;
#pragma unroll
                for (int hh = 0; hh < 8; ++hh) { const f32x4 w = *(const f32x4*)(wff + hh * 2048 + i * 256 + lane * 4); fa[hh] += hv[0] * w[0] + hv[1] * w[1] + hv[2] * w[2] + hv[3] * w[3]; }
            }
            float r4[4], r2[2];
#pragma unroll
            for (int i = 0; i < 4; ++i) { const float mine = b5 ? fa[4 + i] : fa[i], oth = b5 ? fa[i] : fa[4 + i]; r4[i] = mine + __shfl_xor(oth, 32); }
#pragma unroll
            for (int i = 0; i < 2; ++i) { const float mine = b4 ? r4[2 + i] : r4[i], oth = b4 ? r4[i] : r4[2 + i]; r2[i] = mine + __shfl_xor(oth, 16); }
            float v1 = (b3 ? r2[1] : r2[0]) + __shfl_xor(b3 ? r2[0] : r2[1], 8); v1 += __shfl_xor(v1, 4); v1 += __shfl_xor(v1, 2); v1 += __shfl_xor(v1, 1);
            if ((lane & 7) == 0) { const int hh = lane >> 3; const float z = v1 + p.fox_f_bias[hh]; logfa[(size_t)row * 8 + hh] = fminf(z, 0.f) - log1pf(__expf(-fabsf(z))); }
        }
    }
    cvt_stream(p.peer_keys, (bf16_t*)(ws + OFF_KEYS), (size_t)8 * 2 * 128 * 128);
}
__device__ void hg_local_item(const Params& p, unsigned char* smem, int item) {
    const int tid = threadIdx.x, wid = tid >> 6, lane = tid & 63, r = lane & 15, q4 = lane >> 4;
    unsigned char* ws = p.ws;
    const int c = item >> 3, h = item & 7, t0 = c * 64;
    bf16_t* qeS = (bf16_t*)smem;
    bf16_t* keS = qeS + 64 * 136;
    bf16_t* kdT = keS + 64 * 136;
    bf16_t* vT = kdT + 128 * 72;
    bf16_t* Am = vT + 128 * 72;
    float* segsum = (float*)(Am + 64 * 72);
    const float* logf = (const float*)((const unsigned char*)p.out + OUT_LOGF); const bf16_t* qin = (const bf16_t*)(ws + OFF_QIN); const bf16_t* vin = (const bf16_t*)(ws + OFF_V);
    bf16_t* qeG = (bf16_t*)(ws + OFF_QE); float* dec = (float*)(ws + OFF_DEC); float* ointra = (float*)(ws + OFF_OINTRA); bf16_t* LT = (bf16_t*)(ws + OFF_LT);
    float* nmS = segsum + 512;
    {
        const bf16_t* fqp = (const bf16_t*)(ws + OFF_FQ); const bf16_t* fkp = (const bf16_t*)(ws + OFF_FK);
        const size_t o = (size_t)(t0 + (tid >> 3)) * 1024 + h * 128 + (tid & 7) * 16; float sa = 0.f, sb = 0.f;
#pragma unroll
        for (int u = 0; u < 2; ++u) { const u32x4 a = *(const u32x4*)(fqp + o + u * 8), bq = *(const u32x4*)(fkp + o + u * 8);
#pragma unroll
            for (int e = 0; e < 4; ++e) { sa += bflo(a[e]) * bflo(a[e]) + bfhi(a[e]) * bfhi(a[e]); sb += bflo(bq[e]) * bflo(bq[e]) + bfhi(bq[e]) * bfhi(bq[e]); } }
#pragma unroll
        for (int o2 = 1; o2 < 8; o2 <<= 1) { sa += __shfl_xor(sa, o2); sb += __shfl_xor(sb, o2); }
#pragma unroll
        for (int o2 = 8; o2 < 64; o2 <<= 1) { sa = fmaxf(sa, __shfl_xor(sa, o2)); sb = fmaxf(sb, __shfl_xor(sb, o2)); }
        if (lane == 0) { nmS[wid] = sa; nmS[8 + wid] = sb; }
    }
    {
        const int k = tid & 127, seg = tid >> 7;
        float lf[16], bl[16]; float run = 0.f; bf16_t qv[16], vv[16];
        const size_t base = (size_t)(t0 + seg * 16) * 1024 + h * 128 + k;
#pragma unroll
        for (int i = 0; i < 16; ++i) { lf[i] = logf[base + (size_t)i * 1024]; qv[i] = qin[base + (size_t)i * 1024]; vv[i] = vin[base + (size_t)i * 1024]; }
        __builtin_amdgcn_sched_barrier(0);
#pragma unroll
        for (int i = 0; i < 16; ++i) { run += lf[i]; bl[i] = run; }
        segsum[seg * 128 + k] = run;
        __syncthreads();
        float off = 0.f, tot = 0.f;
#pragma unroll
        for (int s = 0; s < 4; ++s) { const float v = segsum[s * 128 + k]; off += (s < seg) ? v : 0.f; tot += v; }
#pragma unroll
        for (int i = 0; i < 16; ++i) {
            const int t = seg * 16 + i; const float bb = bl[i] + off; const float kk = 1.f - __expf(lf[i]);
            const float q = bf2f(qv[i]);
            const bf16_t qe = f2bf(q * __expf(bb));
            qeS[t * 136 + k] = qe; qeG[base + (size_t)i * 1024] = qe;
            keS[t * 136 + k] = f2bf(kk * __expf(-bb));
            kdT[k * 72 + t] = f2bf(kk * __expf(tot - bb));
            vT[k * 72 + t] = vv[i];
        }
        if (seg == 0) dec[item * 128 + k] = __expf(tot);
        if (tid == 0) { float a = 0.f, b2 = 0.f;
#pragma unroll
            for (int w = 0; w < 8; ++w) { a = fmaxf(a, nmS[w]); b2 = fmaxf(b2, nmS[8 + w]); }
            float* nm = (float*)(ws + OFF_NM); nm[item * 2] = a; nm[item * 2 + 1] = b2; }
    }
    __syncthreads();
    {
        const int tt = wid >> 1;
#pragma unroll
        for (int u = 0; u < 2; ++u) {
            const int st = (wid & 1) * 2 + u;
            f32x4 acc = {0.f, 0.f, 0.f, 0.f};
            if (st <= tt) {
#pragma unroll
                for (int ks = 0; ks < 4; ++ks) acc = mfma16(*(const bf16x8*)(qeS + (tt * 16 + r) * 136 + ks * 32 + q4 * 8), *(const bf16x8*)(keS + (st * 16 + r) * 136 + ks * 32 + q4 * 8), acc);
            }
#pragma unroll
            for (int j = 0; j < 4; ++j) { const int t = tt * 16 + q4 * 4 + j, s = st * 16 + r; Am[t * 72 + s] = f2bf((s <= t) ? acc[j] : 0.f); }
        }
    }
    __syncthreads();
    {
        const int tt = wid & 3;
#pragma unroll
        for (int u = 0; u < 4; ++u) {
            const int vt = (wid >> 2) * 4 + u; f32x4 acc = {0.f, 0.f, 0.f, 0.f};
#pragma unroll
            for (int ks = 0; ks < 2; ++ks) acc = mfma16(*(const bf16x8*)(vT + (vt * 16 + r) * 72 + ks * 32 + q4 * 8), *(const bf16x8*)(Am + (tt * 16 + r) * 72 + ks * 32 + q4 * 8), acc);
            *(f32x4*)(ointra + (size_t)(t0 + tt * 16 + r) * 1024 + h * 128 + vt * 16 + q4 * 4) = acc;
        }
    }
    {
        const int vt = wid;
#pragma unroll
        for (int kt = 0; kt < 8; ++kt) {
            f32x4 acc = {0.f, 0.f, 0.f, 0.f};
#pragma unroll
            for (int ks = 0; ks < 2; ++ks) acc = mfma16(*(const bf16x8*)(kdT + (kt * 16 + r) * 72 + ks * 32 + q4 * 8), *(const bf16x8*)(vT + (vt * 16 + r) * 72 + ks * 32 + q4 * 8), acc);
            u32x2 o; o[0] = cvt_pk_bf16(acc[0], acc[1]); o[1] = cvt_pk_bf16(acc[2], acc[3]);
            *(u32x2*)(LT + (size_t)item * 16384 + (vt * 16 + r) * 128 + kt * 16 + q4 * 4) = o;
        }
    }
    __syncthreads();
}
__device__ void fox_scan_item(const Params& p, unsigned char* smem, int h) {
    const int tid = threadIdx.x, wid = tid >> 6, lane = tid & 63;
    unsigned char* ws = p.ws;
    const float* logfa = (const float*)(ws + OFF_LOGFA); float* cf = (float*)(ws + OFF_CFOX) + (size_t)h * T;
    float* wtot = (float*)smem;
    float loc[16]; float run = 0.f;
#pragma unroll
    for (int i = 0; i < 16; ++i) { run += logfa[(size_t)(tid * 16 + i) * 8 + h]; loc[i] = run; }
    float inc = run;
#pragma unroll
    for (int o = 1; o < 64; o <<= 1) { const float n = __shfl_up(inc, o); if (lane >= o) inc += n; }
    if (lane == 63) wtot[wid] = inc;
    __syncthreads();
    float off = 0.f;
#pragma unroll
    for (int w = 0; w < 8; ++w) off += (w < wid) ? wtot[w] : 0.f;
    off += inc - run;
#pragma unroll
    for (int i = 0; i < 16; ++i) cf[tid * 16 + i] = off + loc[i];
    __syncthreads();
}
__device__ void phase_hg_local(const Params& p, unsigned char* smem) {
    for (int it = blockIdx.x; it < 8 + 1024; it += gridDim.x) { if (it < 8) fox_scan_item(p, smem, it); else hg_local_item(p, smem, it - 8); }
}
__device__ void attn_item(const Params& p, unsigned char* smem, int item) {
    const int tid = threadIdx.x, wid = tid >> 6, lane = tid & 63, r = lane & 15, q4 = lane >> 4;
    unsigned char* ws = p.ws;
    const int h = item & 7, qb = item >> 3, t0 = qb * 128, tw = t0 + wid * 16;
    bf16_t* Ks = (bf16_t*)smem;
    bf16_t* vT = Ks + 64 * 136;
    float* csS = (float*)(vT + 128 * 72);
    const bf16_t* fq = (const bf16_t*)(ws + OFF_FQ); const bf16_t* fk = (const bf16_t*)(ws + OFF_FK); const bf16_t* fv = (const bf16_t*)(ws + OFF_FV);
    const float* cf = (const float*)(ws + OFF_CFOX) + (size_t)h * T; bf16_t* ya = (bf16_t*)(ws + OFF_YA);
    bf16x8 qf[4];
#pragma unroll
    for (int ks = 0; ks < 4; ++ks) qf[ks] = *(const bf16x8*)(fq + (size_t)(tw + r) * 1024 + h * 128 + ks * 32 + q4 * 8);
    const int trow = tw + r; const float ct = cf[trow];
    float bqk;
    {
        float a = 0.f, b2 = 0.f;
        if (tid < 128) { const float* nm = (const float*)(ws + OFF_NM) + (size_t)(tid * 8 + h) * 2; a = nm[0]; b2 = nm[1]; }
#pragma unroll
        for (int o2 = 1; o2 < 64; o2 <<= 1) { a = fmaxf(a, __shfl_xor(a, o2)); b2 = fmaxf(b2, __shfl_xor(b2, o2)); }
        __syncthreads();
        if (lane == 0 && wid < 2) { csS[wid] = a; csS[2 + wid] = b2; }
        __syncthreads();
        bqk = sqrtf(fmaxf(csS[0], csS[1])) * sqrtf(fmaxf(csS[2], csS[3])) * 1.01f;
    }
    const float thr = -(26.f + 2.f * bqk);
    const float c0 = cf[t0];
    int lo = 0, hi = 2 * qb;
    while (lo < hi) { const int mid = (lo + hi) >> 1; if (c0 - cf[mid * 64 + 63] >= thr) hi = mid; else lo = mid + 1; }
    int j_lo = lo; const int j_hi = 2 * qb + 1;
    float m = -1e30f, l = 0.f;
    f32x4 O[8];
#pragma unroll
    for (int d = 0; d < 8; ++d) O[d] = (f32x4){0.f, 0.f, 0.f, 0.f};
    u32x4 kreg[2], vreg[2]; float creg = 0.f;
#define ATT_LOAD(J) do { _Pragma("unroll") for (int u = 0; u < 2; ++u) { const int ci = tid + u * 512, key = ci >> 4, dc = ci & 15; const size_t go = (size_t)((J) * 64 + key) * 1024 + h * 128 + dc * 8; \
            kreg[u] = *(const u32x4*)(fk + go); vreg[u] = *(const u32x4*)(fv + go); } if (tid < 64) creg = cf[(J) * 64 + tid]; } while (0)
    ATT_LOAD(j_hi);
    for (int j = j_hi; j >= j_lo; --j) {
        __syncthreads();
#pragma unroll
        for (int u = 0; u < 2; ++u) {
            const int ci = tid + u * 512, key = ci >> 4, dc = ci & 15;
            *(u32x4*)(Ks + key * 136 + dc * 8) = kreg[u];
            const u32x4 vv = vreg[u];
            const int kpos = (((key >> 2) ^ dc) << 2) + (key & 3);
#pragma unroll
            for (int e = 0; e < 4; ++e) { vT[(dc * 8 + 2 * e) * 72 + kpos] = (bf16_t)(vv[e] & 0xffffu); vT[(dc * 8 + 2 * e + 1) * 72 + kpos] = (bf16_t)(vv[e] >> 16); }
        }
        if (tid < 64) csS[tid] = creg;
        __syncthreads();
        if (j > j_lo) ATT_LOAD(j - 1);
        if (j * 64 > tw + 15) continue;
        f32x4 S[4];
#pragma unroll
        for (int nt = 0; nt < 4; ++nt) { S[nt] = (f32x4){0.f, 0.f, 0.f, 0.f};
#pragma unroll
            for (int ks = 0; ks < 4; ++ks) S[nt] = mfma16(*(const bf16x8*)(Ks + (nt * 16 + r) * 136 + ks * 32 + q4 * 8), qf[ks], S[nt]); }
        float mx = -INFINITY;
#pragma unroll
        for (int nt = 0; nt < 4; ++nt)
#pragma unroll
            for (int jj = 0; jj < 4; ++jj) { const int key = nt * 16 + q4 * 4 + jj; float v = S[nt][jj] + ct - csS[key]; v = (j * 64 + key <= trow) ? v : -INFINITY; S[nt][jj] = v; mx = fmaxf(mx, v); }
        mx = fmaxf(mx, __shfl_xor(mx, 16)); mx = fmaxf(mx, __shfl_xor(mx, 32));
        const float mn = fmaxf(m, mx), alpha = __expf(m - mn); m = mn;
        float rs = 0.f;
#pragma unroll
        for (int nt = 0; nt < 4; ++nt)
#pragma unroll
            for (int jj = 0; jj < 4; ++jj) { const float pe = __expf(S[nt][jj] - mn); S[nt][jj] = pe; rs += pe; }
        rs += __shfl_xor(rs, 16); rs += __shfl_xor(rs, 32);
        l = l * alpha + rs;
#pragma unroll
        for (int d = 0; d < 8; ++d) { O[d][0] *= alpha; O[d][1] *= alpha; O[d][2] *= alpha; O[d][3] *= alpha; }
#pragma unroll
        for (int k2 = 0; k2 < 2; ++k2) {
            u32x4 pp; pp[0] = cvt_pk_bf16(S[2 * k2][0], S[2 * k2][1]); pp[1] = cvt_pk_bf16(S[2 * k2][2], S[2 * k2][3]); pp[2] = cvt_pk_bf16(S[2 * k2 + 1][0], S[2 * k2 + 1][1]); pp[3] = cvt_pk_bf16(S[2 * k2 + 1][2], S[2 * k2 + 1][3]);
            const bf16x8 pf = __builtin_bit_cast(bf16x8, pp);
#pragma unroll
            for (int d = 0; d < 8; ++d) {
                const int sw = (d * 2 + (r >> 3)) & 15;
                const u32x2 va = *(const u32x2*)(vT + (d * 16 + r) * 72 + ((((2 * k2) * 4 + q4) ^ sw) << 2)), vb = *(const u32x2*)(vT + (d * 16 + r) * 72 + ((((2 * k2 + 1) * 4 + q4) ^ sw) << 2));
                u32x4 vv; vv[0] = va[0]; vv[1] = va[1]; vv[2] = vb[0]; vv[3] = vb[1];
                O[d] = mfma16(__builtin_bit_cast(bf16x8, vv), pf, O[d]);
            }
        }
        if (j == j_hi - 1 && j > j_lo) {
            float mm = m;
#pragma unroll
            for (int o2 = 1; o2 < 16; o2 <<= 1) mm = fminf(mm, __shfl_xor(mm, o2));
            if (lane == 0) csS[64 + wid] = mm;
            __syncthreads();
            float mmin = csS[64];
#pragma unroll
            for (int w = 1; w < 8; ++w) mmin = fminf(mmin, csS[64 + w]);
            const float thr2 = -(26.f + fmaxf(bqk - mmin, 0.f));
            int lo2 = j_lo, hi2 = j;
            while (lo2 < hi2) { const int mid = (lo2 + hi2) >> 1; if (c0 - cf[mid * 64 + 63] >= thr2) hi2 = mid; else lo2 = mid + 1; }
            j_lo = lo2;
        }
    }
#undef ATT_LOAD
    const float il = 1.f / l;
#pragma unroll
    for (int d = 0; d < 8; ++d) { u32x2 o; o[0] = cvt_pk_bf16(O[d][0] * il, O[d][1] * il); o[1] = cvt_pk_bf16(O[d][2] * il, O[d][3] * il);
        *(u32x2*)(ya + (size_t)trow * 1024 + h * 128 + d * 16 + q4 * 4) = o; }
    __syncthreads();
}
__device__ void hg_scan_item(const Params& p, int item) {
    const int tid = threadIdx.x; unsigned char* ws = p.ws;
    const int h = item & 7, vg = item >> 3; const int v = vg * 4 + (tid >> 7), k = tid & 127;
    const bf16_t* LT = (const bf16_t*)(ws + OFF_LT); const float* dec = (const float*)(ws + OFF_DEC); bf16_t* ST = (bf16_t*)(ws + OFF_ST);
    float s = 0.f;
    bf16_t ltA[16], ltB[16]; float ddA[16], ddB[16];
#define SCAN_LOAD(LT_, DD_, C0) do { _Pragma("unroll") for (int u = 0; u < 16; ++u) { const int it = ((C0) + u) * 8 + h; LT_[u] = LT[(size_t)it * 16384 + v * 128 + k]; DD_[u] = dec[it * 128 + k]; } } while (0)
#define SCAN_STEP(LT_, DD_, C0) do { _Pragma("unroll") for (int u = 0; u < 16; ++u) { const int it = ((C0) + u) * 8 + h; ST[(size_t)it * 16384 + v * 128 + k] = f2bf(s); s = DD_[u] * s + bf2f(LT_[u]); } } while (0)
    SCAN_LOAD(ltA, ddA, 0);
#pragma unroll 1
    for (int c0 = 0; c0 < 128; c0 += 32) {
        __builtin_amdgcn_sched_barrier(0);
        SCAN_LOAD(ltB, ddB, c0 + 16);
        __builtin_amdgcn_sched_barrier(0);
        SCAN_STEP(ltA, ddA, c0);
        __builtin_amdgcn_sched_barrier(0);
        if (c0 + 32 < 128) SCAN_LOAD(ltA, ddA, c0 + 32);
        __builtin_amdgcn_sched_barrier(0);
        SCAN_STEP(ltB, ddB, c0 + 16);
    }
#undef SCAN_LOAD
#undef SCAN_STEP
}
__device__ void phase_attn_scan(const Params& p, unsigned char* smem) {
    for (int it = blockIdx.x; it < 256 + 512; it += gridDim.x) { if (it < 256) hg_scan_item(p, it); else attn_item(p, smem, it - 256); }
}
__device__ void phase_hg_out(const Params& p) {
    const int tid = threadIdx.x, wid = tid >> 6, lane = tid & 63, r = lane & 15, q4 = lane >> 4;
    unsigned char* ws = p.ws;
    const bf16_t* qe = (const bf16_t*)(ws + OFF_QE); const bf16_t* ST = (const bf16_t*)(ws + OFF_ST); const float* ointra = (const float*)(ws + OFF_OINTRA);
    const bf16_t* sgate = (const bf16_t*)(ws + OFF_SGATE); bf16_t* ob = (bf16_t*)(ws + OFF_OB);
    for (int wt = blockIdx.x * 8 + wid; wt < 4096; wt += gridDim.x * 8) {
        const int item = wt >> 2, tt = wt & 3, c = item >> 3, h = item & 7; const int t = c * 64 + tt * 16 + r;
        bf16x8 qf[4];
#pragma unroll
        for (int ks = 0; ks < 4; ++ks) qf[ks] = *(const bf16x8*)(qe + (size_t)t * 1024 + h * 128 + ks * 32 + q4 * 8);
        f32x4 o[8]; float ss = 0.f;
        bf16x8 sf[8][4];
#pragma unroll
        for (int vt = 0; vt < 8; ++vt) {
            o[vt] = *(const f32x4*)(ointra + (size_t)t * 1024 + h * 128 + vt * 16 + q4 * 4);
#pragma unroll
            for (int ks = 0; ks < 4; ++ks) sf[vt][ks] = *(const bf16x8*)(ST + (size_t)item * 16384 + (vt * 16 + r) * 128 + ks * 32 + q4 * 8);
        }
        __builtin_amdgcn_sched_barrier(0);
#pragma unroll
        for (int vt = 0; vt < 8; ++vt) {
            f32x4 acc = o[vt];
#pragma unroll
            for (int ks = 0; ks < 4; ++ks) acc = mfma16(sf[vt][ks], qf[ks], acc);
            o[vt] = acc; ss += acc[0] * acc[0] + acc[1] * acc[1] + acc[2] * acc[2] + acc[3] * acc[3];
        }
        ss += __shfl_xor(ss, 16); ss += __shfl_xor(ss, 32);
        const float rs = rsqrtf(ss * (1.f / 128.f) + EPS);
#pragma unroll
        for (int vt = 0; vt < 8; ++vt) {
            const int col = h * 128 + vt * 16 + q4 * 4; const f32x4 g = *(const f32x4*)(p.hg_norm_g + col); const u32x2 sg = *(const u32x2*)(sgate + (size_t)t * 1024 + col);
            u32x2 w; w[0] = cvt_pk_bf16(o[vt][0] * rs * g[0] * bflo(sg[0]), o[vt][1] * rs * g[1] * bfhi(sg[0])); w[1] = cvt_pk_bf16(o[vt][2] * rs * g[2] * bflo(sg[1]), o[vt][3] * rs * g[3] * bfhi(sg[1]));
            *(u32x2*)(ob + (size_t)t * 1024 + col) = w;
        }
    }
}
__device__ void phase_route(const Params& p, unsigned char* smem) {
    const int tid = threadIdx.x, wid = tid >> 6, lane = tid & 63, r = lane & 15, q4 = lane >> 4;
    unsigned char* ws = p.ws;
    const bf16_t* qp = (const bf16_t*)(ws + OFF_QP); const bf16_t* keys = (const bf16_t*)(ws + OFF_KEYS);
    int* idxo = (int*)(ws + OFF_IDX); float* gateo = (float*)(ws + OFF_GATE);
    float* sc = (float*)smem;
    float* top = sc + 128 * 129;
    float* part = top + 128 * 17;
    for (int item = blockIdx.x; item < 128 * 8; item += gridDim.x) {
        const int h = item & 7, t0 = (item >> 3) * 64;
        {
            const int c = wid >> 2, tt = wid & 3;
            bf16x8 af[4];
#pragma unroll
            for (int ks = 0; ks < 4; ++ks) af[ks] = *(const bf16x8*)(qp + (size_t)(t0 + tt * 16 + r) * 2048 + h * 256 + c * 128 + ks * 32 + q4 * 8);
            const bf16_t* kb = keys + (size_t)((h * 2 + c) * 128 + r) * 128 + q4 * 8;
#pragma unroll
            for (int half = 0; half < 2; ++half) {
                bf16x8 kf[4][4];
#pragma unroll
                for (int n2 = 0; n2 < 4; ++n2)
#pragma unroll
                    for (int ks = 0; ks < 4; ++ks) kf[n2][ks] = *(const bf16x8*)(kb + (size_t)((half * 4 + n2) * 16) * 128 + ks * 32);
                __builtin_amdgcn_sched_barrier(0);
#pragma unroll
                for (int n2 = 0; n2 < 4; ++n2) {
                    const int nt = half * 4 + n2; f32x4 acc = {0.f, 0.f, 0.f, 0.f};
#pragma unroll
                    for (int ks = 0; ks < 4; ++ks) acc = mfma16(af[ks], kf[n2][ks], acc);
#pragma unroll
                    for (int jj = 0; jj < 4; ++jj) sc[(c * 64 + tt * 16 + q4 * 4 + jj) * 129 + nt * 16 + r] = acc[jj];
                }
                __builtin_amdgcn_sched_barrier(0);
            }
        }
        __syncthreads();
        {
            const int row = tid & 127, qq = tid >> 7;
            float lst[16];
#pragma unroll
            for (int i = 0; i < 16; ++i) lst[i] = -INFINITY;
            const float* rowp = sc + row * 129 + qq * 32;
#pragma unroll 4
            for (int n = 0; n < 32; ++n) {
                float x = __uint_as_float((__float_as_uint(rowp[n]) & ~127u) | (unsigned)(qq * 32 + n));
#pragma unroll
                for (int i = 0; i < 16; ++i) { const float hi = fmaxf(lst[i], x); x = fminf(lst[i], x); lst[i] = hi; }
            }
#pragma unroll
            for (int i = 0; i < 16; ++i) part[(row * 4 + qq) * 16 + i] = lst[i];
        }
        __syncthreads();
        if (tid < 128) {
            const float* L = part + tid * 64; int p0 = 0, p1 = 0, p2 = 0, p3 = 0; float h0 = L[0], h1 = L[16], h2 = L[32], h3 = L[48];
#pragma unroll 1
            for (int k = 0; k < 16; ++k) {
                const float m = fmaxf(fmaxf(h0, h1), fmaxf(h2, h3)); top[tid * 17 + k] = m;
                if (m == h0) { ++p0; h0 = p0 < 16 ? L[p0] : -INFINITY; } else if (m == h1) { ++p1; h1 = p1 < 16 ? L[16 + p1] : -INFINITY; }
                else if (m == h2) { ++p2; h2 = p2 < 16 ? L[32 + p2] : -INFINITY; } else { ++p3; h3 = p3 < 16 ? L[48 + p3] : -INFINITY; }
            }
        }
        __syncthreads();
        if (tid < 64) {
            float a[16], bb[16], best[16];
#pragma unroll
            for (int i = 0; i < 16; ++i) { a[i] = top[tid * 17 + i]; bb[i] = top[(64 + tid) * 17 + i]; best[i] = -INFINITY; }
#pragma unroll
            for (int i = 0; i < 16; ++i)
#pragma unroll
                for (int j = 0; j < 16; ++j) if ((i + 1) * (j + 1) <= 16) {
                    float x = __uint_as_float((__float_as_uint(a[i] + bb[j]) & ~255u) | (unsigned)(i * 16 + j));
#pragma unroll
                    for (int k = 0; k < 16; ++k) { const float hi = fmaxf(best[k], x); x = fminf(best[k], x); best[k] = hi; }
                }
            float e[16], sum = 0.f;
#pragma unroll
            for (int k = 0; k < 16; ++k) { e[k] = __expf(best[k] - best[0]); sum += e[k]; }
            const float inv = 1.f / sum; const size_t ob = (size_t)(t0 + tid) * 128 + h * 16;
#pragma unroll
            for (int k = 0; k < 16; ++k) {
                const unsigned pos = __float_as_uint(best[k]) & 255u; const int i = pos >> 4, j = pos & 15;
                const int i0 = (int)(__float_as_uint(top[tid * 17 + i]) & 127u), i1 = (int)(__float_as_uint(top[(64 + tid) * 17 + j]) & 127u);
                idxo[ob + k] = i0 * 128 + i1; gateo[ob + k] = e[k] * inv;
            }
        }
        __syncthreads();
    }
}
__device__ void cvt_rows_fp8(const float* src, unsigned char* dst, float* scl, int wave, int nw) {
    const int lane = threadIdx.x & 63;
#pragma unroll 1
    for (int row0 = wave; row0 < 16384; row0 += nw * 2) {
        f32x4 v[2][8];
#pragma unroll
        for (int rr = 0; rr < 2; ++rr) { const int row = row0 + rr * nw; if (row < 16384) {
#pragma unroll
            for (int k = 0; k < 8; ++k) v[rr][k] = *(const f32x4*)(src + (size_t)row * 2048 + k * 256 + lane * 4); } }
#pragma unroll
        for (int rr = 0; rr < 2; ++rr) { const int row = row0 + rr * nw; if (row < 16384) {
            float mx = 0.f;
#pragma unroll
            for (int k = 0; k < 8; ++k) mx = fmaxf(mx, fmaxf(fmaxf(fabsf(v[rr][k][0]), fabsf(v[rr][k][1])), fmaxf(fabsf(v[rr][k][2]), fabsf(v[rr][k][3]))));
#pragma unroll
            for (int o = 32; o > 0; o >>= 1) mx = fmaxf(mx, __shfl_xor(mx, o));
            const float q = mx > 0.f ? 416.f / mx : 0.f;
#pragma unroll
            for (int k = 0; k < 8; ++k) { int w = 0; w = __builtin_amdgcn_cvt_pk_fp8_f32(v[rr][k][0] * q, v[rr][k][1] * q, w, false); w = __builtin_amdgcn_cvt_pk_fp8_f32(v[rr][k][2] * q, v[rr][k][3] * q, w, true);
                *(int*)(dst + (size_t)row * 2048 + k * 256 + lane * 4) = w; }
            if (lane == 0) scl[row] = mx * (1.f / 416.f);
        } }
    }
}
__device__ void cvt_rows_int4(const float* src, unsigned char* dst, float* scl, int wave, int nw) {
    const int lane = threadIdx.x & 63;
#pragma unroll 1
    for (int row0 = wave; row0 < 16384; row0 += nw * 2) {
        f32x4 v[2][8];
#pragma unroll
        for (int rr = 0; rr < 2; ++rr) { const int row = row0 + rr * nw; if (row < 16384) {
#pragma unroll
            for (int k = 0; k < 8; ++k) v[rr][k] = *(const f32x4*)(src + (size_t)row * 2048 + (k >> 2) * 1024 + lane * 16 + (k & 3) * 4); } }
#pragma unroll
        for (int rr = 0; rr < 2; ++rr) { const int row = row0 + rr * nw; if (row < 16384) {
            float mx = 0.f, ss = 0.f;
#pragma unroll
            for (int k = 0; k < 8; ++k)
#pragma unroll
                for (int e = 0; e < 4; ++e) { mx = fmaxf(mx, fabsf(v[rr][k][e])); ss += v[rr][k][e] * v[rr][k][e]; }
#pragma unroll
            for (int o = 32; o > 0; o >>= 1) { mx = fmaxf(mx, __shfl_xor(mx, o)); ss += __shfl_xor(ss, o); }
            const float sc = fminf(mx, 3.f * sqrtf(ss * (1.f / 2048.f))) * (1.f / 7.f), inv = sc > 0.f ? 1.f / sc : 0.f;
            u32x4 pk;
#pragma unroll
            for (int q = 0; q < 4; ++q) { unsigned w = 0u;
#pragma unroll
                for (int j = 0; j < 8; ++j) { const int jj = q * 8 + j; const float x = v[rr][jj >> 2][jj & 3] * inv; const int qi = (int)rintf(fminf(fmaxf(x, -7.f), 7.f)) + 8;
                    w |= (unsigned)qi << (8 * (j >> 1) + 4 * (j & 1)); }
                pk[q] = w; }
            *(u32x4*)(dst + (size_t)row * 1024 + lane * 16) = pk;
            if (lane == 0) scl[row] = sc;
        } }
    }
}
__device__ __forceinline__ float gelu_tanh(float x) { const float u = 0.7978845608028654f * (x + 0.044715f * x * x * x); const float t = 1.f - 2.f / (1.f + __expf(2.f * u)); return 0.5f * x * (1.f + t); }
__device__ void phase_peer(const Params& p) {
    const int tid = threadIdx.x, wid = tid >> 6, lane = tid & 63;
    unsigned char* ws = p.ws;
    const bf16_t* xg2 = (const bf16_t*)(ws + OFF_XG2); const float* sumsq = (const float*)(ws + OFF_SUMSQ);
    const int* idx = (const int*)(ws + OFF_IDX); const float* gate = (const float*)(ws + OFF_GATE);
    const unsigned char* U8 = ws + OFF_U8; const unsigned char* V8 = ws + OFF_V8; const float* usc = (const float*)(ws + OFF_USC); const float* vsc = (const float*)(ws + OFF_VSC);
    for (int t = blockIdx.x * 8 + wid; t < T; t += gridDim.x * 8) {
        const int tu = __builtin_amdgcn_readfirstlane(t);
        const float rs = row_rstd(sumsq, tu);
        float xv[32];
#pragma unroll
        for (int i = 0; i < 2; ++i)
#pragma unroll
            for (int hq = 0; hq < 2; ++hq) { const u32x4 a = *(const u32x4*)(xg2 + (size_t)tu * 2048 + i * 1024 + lane * 16 + hq * 8);
#pragma unroll
                for (int e = 0; e < 4; ++e) { xv[i * 16 + hq * 8 + 2 * e] = bflo(a[e]) * rs; xv[i * 16 + hq * 8 + 2 * e + 1] = bfhi(a[e]) * rs; } }
        const int e0 = idx[(size_t)tu * 128 + lane], e1 = idx[(size_t)tu * 128 + 64 + lane];
        const float us0 = usc[e0], us1 = usc[e1], vs0 = vsc[e0], vs1 = vsc[e1], g0 = gate[(size_t)tu * 128 + lane], g1 = gate[(size_t)tu * 128 + 64 + lane];
        float w0 = 0.f, w1 = 0.f;
        const bool b5 = (lane & 32) != 0, b4 = (lane & 16) != 0;
#define P10_ISSUE(BUF, TAB, B) do { _Pragma("unroll") for (int u = 0; u < 4; ++u) { const int e = __builtin_amdgcn_readlane((B) < 16 ? e0 : e1, (((B) & 15) << 2) + u); \
            const unsigned char* rp = (TAB) + (size_t)e * 2048 + lane * 16; BUF[u][0] = *(const u32x4*)rp; BUF[u][1] = *(const u32x4*)(rp + 1024); } } while (0)
#define P10_UDOT(BUF, B) do { float d[4]; _Pragma("unroll") for (int u = 0; u < 4; ++u) { float sacc = 0.f; _Pragma("unroll") for (int i = 0; i < 2; ++i) _Pragma("unroll") for (int q = 0; q < 4; ++q) { \
                const f32x2_t lo = __builtin_amdgcn_cvt_pk_f32_fp8((int)BUF[u][i][q], false), hi = __builtin_amdgcn_cvt_pk_f32_fp8((int)BUF[u][i][q], true); \
                sacc += lo[0] * xv[i * 16 + 4 * q] + lo[1] * xv[i * 16 + 4 * q + 1] + hi[0] * xv[i * 16 + 4 * q + 2] + hi[1] * xv[i * 16 + 4 * q + 3]; } d[u] = sacc; } \
            float r2[2]; _Pragma("unroll") for (int i = 0; i < 2; ++i) { const float mine = b5 ? d[2 + i] : d[i], oth = b5 ? d[i] : d[2 + i]; r2[i] = mine + __shfl_xor(oth, 32); } \
            float v1 = (b4 ? r2[1] : r2[0]) + __shfl_xor(b4 ? r2[0] : r2[1], 16); v1 += __shfl_xor(v1, 8); v1 += __shfl_xor(v1, 4); v1 += __shfl_xor(v1, 2); v1 += __shfl_xor(v1, 1); \
            const float mineT = __shfl(v1, (lane & 3) << 4);        \
            if ((lane >> 2) == ((B) & 15)) { if ((B) < 16) w0 = mineT; else w1 = mineT; } } while (0)
#define P10_ISSUE_U(BUF, B) do { _Pragma("unroll") for (int u = 0; u < 4; ++u) { const int e = __builtin_amdgcn_readlane((B) < 16 ? e0 : e1, (((B) & 15) << 2) + u); \
            BUF[u][0] = *(const u32x4*)(U8 + (size_t)e * 1024 + lane * 16); } } while (0)
#define P10_UDOT4B(BUF, B) do { float d[4]; _Pragma("unroll") for (int u = 0; u < 4; ++u) { float sacc = 0.f; _Pragma("unroll") for (int q = 0; q < 4; ++q) { \
                const unsigned wq_ = BUF[u][0][q], lo_ = wq_ & 0x0f0f0f0fu, hi_ = (wq_ >> 4) & 0x0f0f0f0fu; \
                _Pragma("unroll") for (int k_ = 0; k_ < 4; ++k_) sacc += (float)((lo_ >> (8 * k_)) & 255u) * xv[8 * q + 2 * k_] + (float)((hi_ >> (8 * k_)) & 255u) * xv[8 * q + 2 * k_ + 1]; } d[u] = sacc; } \
            float r2[2]; _Pragma("unroll") for (int i = 0; i < 2; ++i) { const float mine = b5 ? d[2 + i] : d[i], oth = b5 ? d[i] : d[2 + i]; r2[i] = mine + __shfl_xor(oth, 32); } \
            float v1 = (b4 ? r2[1] : r2[0]) + __shfl_xor(b4 ? r2[0] : r2[1], 16); v1 += __shfl_xor(v1, 8); v1 += __shfl_xor(v1, 4); v1 += __shfl_xor(v1, 2); v1 += __shfl_xor(v1, 1); \
            const float mineT = __shfl(v1, (lane & 3) << 4); \
            if ((lane >> 2) == ((B) & 15)) { if ((B) < 16) w0 = mineT; else w1 = mineT; } } while (0)
#define P10_VACC(BUF, B) do { _Pragma("unroll") for (int u = 0; u < 4; ++u) { const float w = __uint_as_float((unsigned)__builtin_amdgcn_readlane((int)__float_as_uint((B) < 16 ? w0 : w1), (((B) & 15) << 2) + u)); \
            _Pragma("unroll") for (int i = 0; i < 2; ++i) _Pragma("unroll") for (int q = 0; q < 4; ++q) { \
                const f32x2_t lo = __builtin_amdgcn_cvt_pk_f32_fp8((int)BUF[u][i][q], false), hi = __builtin_amdgcn_cvt_pk_f32_fp8((int)BUF[u][i][q], true); \
                acc[i * 16 + 4 * q] += w * lo[0]; acc[i * 16 + 4 * q + 1] += w * lo[1]; acc[i * 16 + 4 * q + 2] += w * hi[0]; acc[i * 16 + 4 * q + 3] += w * hi[1]; } } } while (0)
        u32x4 bufA[4][2], bufB[4][2];
        float sx = 0.f;
#pragma unroll
        for (int j = 0; j < 32; ++j) sx += xv[j];
        const float SX8 = 8.f * wave_sum(sx);
        P10_ISSUE_U(bufA, 0);
#pragma unroll 1
        for (int b2 = 0; b2 < 32; b2 += 2) {
            P10_ISSUE_U(bufB, b2 + 1);
            P10_UDOT4B(bufA, b2);
            if (b2 + 2 < 32) P10_ISSUE_U(bufA, b2 + 2); else P10_ISSUE(bufA, V8, 0);
            P10_UDOT4B(bufB, b2 + 1);
        }
        w0 = gelu_tanh((w0 - SX8) * us0) * g0 * vs0; w1 = gelu_tanh((w1 - SX8) * us1) * g1 * vs1;
        float acc[32];
#pragma unroll
        for (int i = 0; i < 32; ++i) acc[i] = 0.f;
#pragma unroll 1
        for (int b2 = 0; b2 < 32; b2 += 2) {
            P10_ISSUE(bufB, V8, b2 + 1);
            P10_VACC(bufA, b2);
            if (b2 + 2 < 32) P10_ISSUE(bufA, V8, b2 + 2);
            P10_VACC(bufB, b2 + 1);
        }
#undef P10_ISSUE
#undef P10_UDOT
#undef P10_ISSUE_U
#undef P10_UDOT4B
#undef P10_VACC
        float* orow = p.out + (size_t)tu * 2048; float ss = 0.f;
#pragma unroll
        for (int i = 0; i < 2; ++i)
#pragma unroll
            for (int c = 0; c < 4; ++c) { const f32x4 a = *(const f32x4*)(orow + i * 1024 + lane * 16 + c * 4);
#pragma unroll
                for (int e = 0; e < 4; ++e) { acc[i * 16 + c * 4 + e] += a[e]; ss += acc[i * 16 + c * 4 + e] * acc[i * 16 + c * 4 + e]; } }
        ss = wave_sum(ss); const float rf = rsqrtf(ss * (1.f / 2048.f) + EPS);
#pragma unroll
        for (int i = 0; i < 2; ++i)
#pragma unroll
            for (int c = 0; c < 4; ++c) { const f32x4 g = *(const f32x4*)(p.norm_f_g + i * 1024 + lane * 16 + c * 4); f32x4 o;
#pragma unroll
                for (int e = 0; e < 4; ++e) o[e] = acc[i * 16 + c * 4 + e] * rf * g[e];
                *(f32x4*)(orow + i * 1024 + lane * 16 + c * 4) = o; }
    }
}

#ifndef DBG_STOP
#define DBG_STOP 0
#endif
__device__ void dbg_dump(const Params& p, const void* A, int a_f32, const void* B, int b_f32) {
    for (size_t i = (size_t)blockIdx.x * 512 + threadIdx.x; i < (size_t)T * 2048; i += (size_t)gridDim.x * 512) {
        const size_t t = i >> 11; const int c = (int)(i & 2047); const void* S = c < 1024 ? A : B; const int f = c < 1024 ? a_f32 : b_f32; const size_t o = t * 1024 + (c & 1023);
        p.out[i] = f ? ((const float*)S)[o] : bf2f(((const bf16_t*)S)[o]);
    }
}
__device__ __forceinline__ void fast_barrier(unsigned* bar, unsigned k) {
    asm volatile("s_waitcnt vmcnt(0)" ::: "memory");
    __syncthreads();
    if (threadIdx.x == 0) {
        __builtin_amdgcn_fence(__ATOMIC_RELEASE, "agent");
        asm volatile("s_waitcnt vmcnt(0)" ::: "memory");
        const unsigned g = blockIdx.x & 7u, ngr = gridDim.x < 8u ? gridDim.x : 8u, gsz = (gridDim.x - g + 7u) >> 3;
        const unsigned v = __hip_atomic_fetch_add(bar + 64u * g, 1u, __ATOMIC_RELAXED, __HIP_MEMORY_SCOPE_AGENT);
        if (v + 1u == gsz * k) {
            const unsigned t = __hip_atomic_fetch_add(bar + 64u * 8u, 1u, __ATOMIC_RELAXED, __HIP_MEMORY_SCOPE_AGENT);
            if (t + 1u == ngr * k) { for (unsigned j = 0; j < ngr; ++j) __hip_atomic_store(bar + 64u * (16u + j), k, __ATOMIC_RELAXED, __HIP_MEMORY_SCOPE_AGENT); }
        }
        while (__hip_atomic_load(bar + 64u * (16u + g), __ATOMIC_RELAXED, __HIP_MEMORY_SCOPE_AGENT) < k) __builtin_amdgcn_s_sleep(2);
        __builtin_amdgcn_fence(__ATOMIC_ACQUIRE, "agent");
        asm volatile("s_waitcnt vmcnt(0)" ::: "memory");
    }
    __syncthreads();
}
__global__ void __launch_bounds__(512, 2) fwd_megakernel(Params p) {
    extern __shared__ __attribute__((aligned(16))) unsigned char smem[];
    cg::grid_group grid = cg::this_grid();
#define GSYNC() do { asm volatile("s_waitcnt vmcnt(0)" ::: "memory"); grid.sync(); \
        if (threadIdx.x < 64) { __builtin_amdgcn_fence(__ATOMIC_ACQUIRE, "agent"); asm volatile("s_waitcnt vmcnt(0)" ::: "memory"); } __syncthreads(); } while (0)
    unsigned char* ws = p.ws;
    phase_prep(p, smem);
    if (p.ws == nullptr) GSYNC();
    fast_barrier((unsigned*)(ws + OFF_BAR), 1u);
    {
        FZ f; f.fq = (bf16_t*)(ws + OFF_FQ); f.fk = (bf16_t*)(ws + OFF_FK); f.fv = (bf16_t*)(ws + OFF_FV); f.qin = (bf16_t*)(ws + OFF_QIN); f.v = (bf16_t*)(ws + OFF_V);
        f.sgate = (bf16_t*)(ws + OFF_SGATE); f.sga = ws + OFF_SGA; f.sgb = ws + OFF_SGB; f.logfo = (float*)((unsigned char*)p.out + OUT_LOGF); f.lbl = p.hg_lb_logits;
        run_gemm(smem, (const bf16_t*)p.out, (const bf16_t*)(ws + OFF_WIN), T, NZ, 2048, f);
    }
    {
        const int nunits = (T / 256) * (NZ / 256), rem = nunits % (int)gridDim.x;
        const int first = rem ? rem : 0, nidle = (int)gridDim.x - first;
        if ((int)blockIdx.x >= first) { const int wv = ((int)blockIdx.x - first) * 8 + (int)(threadIdx.x >> 6);
            cvt_rows_int4(p.peer_u, ws + OFF_U8, (float*)(ws + OFF_USC), wv, nidle * 8); cvt_rows_fp8(p.peer_v, ws + OFF_V8, (float*)(ws + OFF_VSC), wv, nidle * 8); }
    }
    fast_barrier((unsigned*)(ws + OFF_BAR), 2u);
    phase_hg_local(p, smem);
    fast_barrier((unsigned*)(ws + OFF_BAR), 3u);
    phase_attn_scan(p, smem);
    fast_barrier((unsigned*)(ws + OFF_BAR), 4u);
    if (DBG_STOP == 3) { dbg_dump(p, ws + OFF_YA, 0, ws + OFF_ST, 0); return; }
    phase_hg_out(p);
    fast_barrier((unsigned*)(ws + OFF_BAR), 5u);
    if (DBG_STOP == 4) { dbg_dump(p, ws + OFF_YA, 0, ws + OFF_OB, 0); return; }
    {
        FA fa; fa.merged = (bf16_t*)(ws + OFF_MERGED); fa.sg = ws + OFF_SGA;
        run_gemm(smem, (const bf16_t*)(ws + OFF_YA), (const bf16_t*)(ws + OFF_WA), T, 2048, 1024, fa);
        FB fb; fb.merged = (bf16_t*)(ws + OFF_MERGED); fb.sg = ws + OFF_SGB;
        run_gemm(smem, (const bf16_t*)(ws + OFF_OB), (const bf16_t*)(ws + OFF_WB), T, 2048, 1024, fb);
    }
    fast_barrier((unsigned*)(ws + OFF_BAR), 6u);
    {
        FO f; f.x = p.x; f.g2 = p.norm2_g; f.x1 = p.out; f.xg2 = (bf16_t*)(ws + OFF_XG2); f.sumsq = (float*)(ws + OFF_SUMSQ);
        run_gemm(smem, (const bf16_t*)(ws + OFF_MERGED), (const bf16_t*)(ws + OFF_WO), T, 2048, 2048, f);
    }
    fast_barrier((unsigned*)(ws + OFF_BAR), 7u);
    if (DBG_STOP == 6) { dbg_dump(p, ws + OFF_XG2, 0, ws + OFF_MERGED, 0); return; }
    {
        FQ f; f.qp = (bf16_t*)(ws + OFF_QP); f.sumsq = (const float*)(ws + OFF_SUMSQ);
        run_gemm(smem, (const bf16_t*)(ws + OFF_XG2), (const bf16_t*)(ws + OFF_WQ), T, 2048, 2048, f);
    }
    fast_barrier((unsigned*)(ws + OFF_BAR), 8u);
    if (DBG_STOP == 8) { dbg_dump(p, ws + OFF_QP, 0, ws + OFF_QP + 16 * MiB, 0); return; }
    phase_route(p, smem);
    fast_barrier((unsigned*)(ws + OFF_BAR), 9u);
    phase_peer(p);
}

extern "C" void kernel_launch(void* const* d_in, const int* in_sizes, int n_in, void* d_out, int out_size, void* d_ws, size_t ws_size, hipStream_t stream) {
    static int grid_blocks = 0;
    if (!grid_blocks) {
        int dev = 0, cus = 0, per_cu = 0;
        (void)hipGetDevice(&dev);
        (void)hipDeviceGetAttribute(&cus, hipDeviceAttributeMultiprocessorCount, dev);
        (void)hipFuncSetAttribute((const void*)fwd_megakernel, hipFuncAttributeMaxDynamicSharedMemorySize, LDS_BYTES);
        (void)hipOccupancyMaxActiveBlocksPerMultiprocessor(&per_cu, (const void*)fwd_megakernel, 512, LDS_BYTES);
        if (per_cu < 1) per_cu = 1;
        grid_blocks = cus * per_cu;
        if (ws_size < WS_END) fprintf(stderr, "kernel_launch: workspace too small (%zu < %zu)\n", ws_size, (size_t)WS_END);
    }
    Params p{};
    p.x = (const float*)d_in[0]; p.norm1_g = (const float*)d_in[1]; p.w_in = (const float*)d_in[2]; p.fox_f_bias = (const float*)d_in[3]; p.hg_lb_logits = (const float*)d_in[4];
    p.hg_norm_g = (const float*)d_in[5]; p.w_a_up = (const float*)d_in[6]; p.w_b_up = (const float*)d_in[7]; p.w_o = (const float*)d_in[8]; p.norm2_g = (const float*)d_in[9];
    p.peer_wq = (const float*)d_in[10]; p.peer_keys = (const float*)d_in[11]; p.peer_u = (const float*)d_in[12]; p.peer_v = (const float*)d_in[13]; p.norm_f_g = (const float*)d_in[14];
    p.out = (float*)d_out; p.ws = (unsigned char*)d_ws;
    (void)hipMemsetAsync((unsigned char*)d_ws + OFF_BAR, 0, BAR_BYTES, stream);
    void* args[] = {&p};
    hipError_t e = hipLaunchCooperativeKernel((const void*)fwd_megakernel, dim3(grid_blocks), dim3(512), args, LDS_BYTES, stream);
    if (e != hipSuccess) fprintf(stderr, "cooperative launch failed: %s (grid %d)\n", hipGetErrorString(e), grid_blocks);
}
```
